# Optimizing an MI355X kernel written in HIP

```python
import math
import jax, jax.numpy as jnp
from jax import lax
import numpy as np

D_MODEL = 1024
BATCH = 8
SEQ = 2048
DEPTH = 1

MIX_WIDTH = D_MODEL
ATTN_WIDTH = MIX_WIDTH // 2
SSM_WIDTH = MIX_WIDTH - ATTN_WIDTH
ATTN_HEADS = 4
ATTN_VDIM = ATTN_WIDTH // ATTN_HEADS
ATTN_QKDIM = ATTN_VDIM // 2
Q_BLOCK = 128
SSM_GROUP = 16
SSM_GROUPS = SSM_WIDTH // SSM_GROUP
SSM_STATE = 64
D_FF = 4 * D_MODEL
EPS = 1e-6
IN_WIDTH = 3 * ATTN_WIDTH + SSM_WIDTH

kernel_name = 'hybrid_diffattn_s5_encoder_block'


def rmsnorm(x, g):
    xf = x.astype(jnp.float32)
    y = xf * lax.rsqrt(jnp.mean(xf * xf, axis=-1, keepdims=True) + EPS)
    return (y * g.astype(jnp.float32)).astype(x.dtype)


def alibi_slopes(n_heads):
    return jnp.asarray([2.0 ** (-8.0 * (h + 1) / n_heads) for h in range(n_heads)], dtype=jnp.float32)


def diff_attention(q, k, v, lam):
    b, s, h, _, d = q.shape
    nblk = s // Q_BLOCK
    scale = d ** -0.5
    slopes = alibi_slopes(h)
    kpos = jnp.arange(s, dtype=jnp.int32)
    qb = q.reshape(b, nblk, Q_BLOCK, h, 2, d).transpose(1, 0, 2, 3, 4, 5)

    def block(args):
        qi, i = args
        qpos = i * Q_BLOCK + jnp.arange(Q_BLOCK, dtype=jnp.int32)
        dist = jnp.abs(qpos[:, None] - kpos[None, :]).astype(jnp.float32)
        bias = -slopes[:, None, None] * dist[None]
        sc = jnp.einsum('bqhcd,bkhcd->bhcqk', qi, k).astype(jnp.float32) * scale
        p = jax.nn.softmax(sc + bias[None, :, None], axis=-1)
        a = p[:, :, 0] - lam * p[:, :, 1]
        return jnp.einsum('bhqk,bkhe->bqhe', a.astype(v.dtype), v)

    o = lax.map(block, (qb, jnp.arange(nblk, dtype=jnp.int32)))
    return o.transpose(1, 0, 2, 3, 4).reshape(b, s, h, v.shape[-1])


def s5_direction(u, lam_re, lam_im, log_dt, b_re, b_im, c_re, c_im):
    dt = jnp.exp(log_dt)[:, None]
    mag = jnp.exp(lam_re * dt)
    ang = lam_im * dt
    ar = mag * jnp.cos(ang)
    ai = mag * jnp.sin(ang)
    nr = ar - 1.0
    den = lam_re * lam_re + lam_im * lam_im
    cr = (nr * lam_re + ai * lam_im) / den
    ci = (ai * lam_re - nr * lam_im) / den
    bbr = cr[..., None] * b_re - ci[..., None] * b_im
    bbi = cr[..., None] * b_im + ci[..., None] * b_re
    bu_r = jnp.einsum('bsgh,gph->bsgp', u, bbr)
    bu_i = jnp.einsum('bsgh,gph->bsgp', u, bbi)
    a_r = jnp.broadcast_to(ar, bu_r.shape)
    a_i = jnp.broadcast_to(ai, bu_r.shape)

    def combine(e1, e2):
        a1r, a1i, b1r, b1i = e1
        a2r, a2i, b2r, b2i = e2
        return (a2r * a1r - a2i * a1i,
                a2r * a1i + a2i * a1r,
                a2r * b1r - a2i * b1i + b2r,
                a2r * b1i + a2i * b1r + b2i)

    _, _, xr, xi = lax.associative_scan(combine, (a_r, a_i, bu_r, bu_i), axis=1)
    return jnp.einsum('bsgp,ghp->bsgh', xr, c_re) - jnp.einsum('bsgp,ghp->bsgh', xi, c_im)


def bi_s5_glu(u, lam_re, lam_im, log_dt, b_re, b_im, c_re, c_im, d_skip, w_glu, b_glu):
    bsz, s, _ = u.shape
    uf = u.astype(jnp.float32).reshape(bsz, s, SSM_GROUPS, SSM_GROUP)
    f32 = lambda t: t.astype(jnp.float32)
    y_f = s5_direction(uf, f32(lam_re[0]), f32(lam_im[0]), f32(log_dt[0]), f32(b_re[0]), f32(b_im[0]), f32(c_re[0]), f32(c_im[0]))
    y_b = s5_direction(uf[:, ::-1], f32(lam_re[1]), f32(lam_im[1]), f32(log_dt[1]), f32(b_re[1]), f32(b_im[1]), f32(c_re[1]), f32(c_im[1]))[:, ::-1]
    y = (y_f + y_b).reshape(bsz, s, SSM_WIDTH) + f32(d_skip) * u.astype(jnp.float32)
    z = jax.nn.gelu(y, approximate=False)
    out = z * jax.nn.sigmoid(z @ f32(w_glu) + f32(b_glu))
    return out.astype(u.dtype)


def setup_inputs(seed: int = 0) -> dict:
    key = jax.random.key(seed)
    ks = jax.random.split(key, 24)
    f = jnp.float32
    nrm = lambda k, shape, std: jax.random.normal(k, shape, f) * std
    x = jax.random.normal(ks[0], (BATCH, SEQ, D_MODEL), f)
    norm1_g = 1.0 + nrm(ks[1], (DEPTH, D_MODEL), 0.02)
    w_in = nrm(ks[2], (DEPTH, D_MODEL, IN_WIDTH), D_MODEL ** -0.5)
    lam_q1 = nrm(ks[3], (DEPTH, ATTN_QKDIM), 0.1)
    lam_k1 = nrm(ks[4], (DEPTH, ATTN_QKDIM), 0.1)
    lam_q2 = nrm(ks[5], (DEPTH, ATTN_QKDIM), 0.1)
    lam_k2 = nrm(ks[6], (DEPTH, ATTN_QKDIM), 0.1)
    subln_g = 1.0 + nrm(ks[7], (DEPTH, ATTN_VDIM), 0.02)
    n_idx = jnp.arange(SSM_STATE, dtype=f)
    sshape = (DEPTH, 2, SSM_GROUPS, SSM_STATE)
    ssm_lam_re = -0.5 * jnp.exp(nrm(ks[8], sshape, 0.02))
    ssm_lam_im = math.pi * n_idx + nrm(ks[9], sshape, 0.02)
    ssm_log_dt = jax.random.uniform(ks[10], (DEPTH, 2, SSM_GROUPS), f, math.log(1e-3), math.log(1e-1))
    bshape = (DEPTH, 2, SSM_GROUPS, SSM_STATE, SSM_GROUP)
    cshape = (DEPTH, 2, SSM_GROUPS, SSM_GROUP, SSM_STATE)
    ssm_b_re = nrm(ks[11], bshape, (2.0 * SSM_GROUP) ** -0.5)
    ssm_b_im = nrm(ks[12], bshape, (2.0 * SSM_GROUP) ** -0.5)
    ssm_c_re = nrm(ks[13], cshape, (2.0 * SSM_STATE) ** -0.5)
    ssm_c_im = nrm(ks[14], cshape, (2.0 * SSM_STATE) ** -0.5)
    ssm_d = nrm(ks[15], (DEPTH, SSM_WIDTH), 1.0)
    w_glu = nrm(ks[16], (DEPTH, SSM_WIDTH, SSM_WIDTH), SSM_WIDTH ** -0.5)
    b_glu = nrm(ks[17], (DEPTH, SSM_WIDTH), 0.02)
    w_out = nrm(ks[18], (DEPTH, MIX_WIDTH, D_MODEL), MIX_WIDTH ** -0.5)
    norm2_g = 1.0 + nrm(ks[19], (DEPTH, D_MODEL), 0.02)
    w_mlp1 = nrm(ks[20], (DEPTH, D_MODEL, D_FF), D_MODEL ** -0.5)
    w_mlp2 = nrm(ks[21], (DEPTH, D_FF, D_MODEL), D_FF ** -0.5)
    final_g = 1.0 + nrm(ks[22], (D_MODEL,), 0.02)
    return {'x': x, 'norm1_g': norm1_g, 'w_in': w_in, 'lam_q1': lam_q1, 'lam_k1': lam_k1,
            'lam_q2': lam_q2, 'lam_k2': lam_k2, 'subln_g': subln_g,
            'ssm_lam_re': ssm_lam_re, 'ssm_lam_im': ssm_lam_im, 'ssm_log_dt': ssm_log_dt,
            'ssm_b_re': ssm_b_re, 'ssm_b_im': ssm_b_im, 'ssm_c_re': ssm_c_re, 'ssm_c_im': ssm_c_im,
            'ssm_d': ssm_d, 'w_glu': w_glu, 'b_glu': b_glu, 'w_out': w_out, 'norm2_g': norm2_g,
            'w_mlp1': w_mlp1, 'w_mlp2': w_mlp2, 'final_g': final_g}


def reference(x, norm1_g, w_in, lam_q1, lam_k1, lam_q2, lam_k2, subln_g,
              ssm_lam_re, ssm_lam_im, ssm_log_dt, ssm_b_re, ssm_b_im, ssm_c_re, ssm_c_im,
              ssm_d, w_glu, b_glu, w_out, norm2_g, w_mlp1, w_mlp2, final_g):
    bsz, s, _ = x.shape
    h = x
    for l in range(DEPTH):
        lambda_init = 0.8 - 0.6 * math.exp(-0.3 * l)
        hn = rmsnorm(h, norm1_g[l])
        proj = hn @ w_in[l]
        q = proj[..., :ATTN_WIDTH].reshape(bsz, s, ATTN_HEADS, 2, ATTN_QKDIM)
        k = proj[..., ATTN_WIDTH:2 * ATTN_WIDTH].reshape(bsz, s, ATTN_HEADS, 2, ATTN_QKDIM)
        v = proj[..., 2 * ATTN_WIDTH:3 * ATTN_WIDTH].reshape(bsz, s, ATTN_HEADS, ATTN_VDIM)
        u = proj[..., 3 * ATTN_WIDTH:]
        lam = (jnp.exp(jnp.sum(lam_q1[l].astype(jnp.float32) * lam_k1[l].astype(jnp.float32)))
               - jnp.exp(jnp.sum(lam_q2[l].astype(jnp.float32) * lam_k2[l].astype(jnp.float32)))
               + lambda_init)
        att = diff_attention(q, k, v, lam)
        att = rmsnorm(att, subln_g[l]) * (1.0 - lambda_init)
        ssm = bi_s5_glu(u, ssm_lam_re[l], ssm_lam_im[l], ssm_log_dt[l], ssm_b_re[l], ssm_b_im[l],
                        ssm_c_re[l], ssm_c_im[l], ssm_d[l], w_glu[l], b_glu[l])
        mix = jnp.concatenate([att.reshape(bsz, s, ATTN_WIDTH).astype(h.dtype), ssm.astype(h.dtype)], axis=-1)
        h = h + mix @ w_out[l]
        hn2 = rmsnorm(h, norm2_g[l])
        h = h + jnp.square(jax.nn.relu(hn2 @ w_mlp1[l])) @ w_mlp2[l]
    return rmsnorm(h, final_g)
```

```cpp
#include <hip/hip_runtime.h>
#include <cstdio>
#include <cstdint>
#include <cmath>

typedef unsigned short bf16_t;

constexpr int BATCH = 8, SEQ = 2048, DM = 1024, M_TOK = BATCH * SEQ;
constexpr int NPROJ = 2048, FF = 4096, NH = 4, VD = 128, QKD = 64, SSMW = 512, NG = 32, GC = 16, NP = 64;
constexpr float EPS = 1e-6f;
constexpr float LAMBDA_INIT = 0.2f;

constexpr size_t MiB = 1u << 20;
constexpr size_t WS_WIN = 2 * MiB, WS_WGLU = 6 * MiB, WS_WOUT = 7 * MiB, WS_W1 = 10 * MiB, WS_W2 = 18 * MiB;
constexpr size_t WS_SS1 = 36 * MiB, WS_SS2 = 37 * MiB;
constexpr size_t WS_XN = 40 * MiB, WS_PROJ = 72 * MiB, WS_MIX = 136 * MiB, WS_Z = 168 * MiB, WS_H = 72 * MiB, WS_Y = 200 * MiB;

__device__ __forceinline__ float bf2f(bf16_t v) { return __uint_as_float((unsigned)v << 16); }
__device__ __forceinline__ bf16_t f2bf(float f) { unsigned u = __float_as_uint(f); return (bf16_t)((u + 0x7fffu + ((u >> 16) & 1u)) >> 16); }
__device__ __forceinline__ float wave_sum(float v) {
#pragma unroll
    for (int o = 1; o < 64; o <<= 1) v += __shfl_xor(v, o);
    return v;
}
__device__ __forceinline__ float wave_max(float v) {
#pragma unroll
    for (int o = 1; o < 64; o <<= 1) v = fmaxf(v, __shfl_xor(v, o));
    return v;
}

__global__ void __launch_bounds__(256) k_transpose_w(const float* __restrict__ W, const float* __restrict__ scale, bf16_t* __restrict__ WT, int K, int N) {
    __shared__ float t[32][33];
    const int k0 = blockIdx.y * 32, n0 = blockIdx.x * 32, tx = threadIdx.x & 31, ty = threadIdx.x >> 5;
    for (int i = ty; i < 32; i += 8) { float s = scale ? scale[k0 + i] : 1.f; t[i][tx] = W[(size_t)(k0 + i) * N + n0 + tx] * s; }
    __syncthreads();
    for (int i = ty; i < 32; i += 8) WT[(size_t)(n0 + i) * K + k0 + tx] = f2bf(t[tx][i]);
}

__global__ void __launch_bounds__(256) k_rmsnorm_bf16(const float* __restrict__ x, const float* __restrict__ g, bf16_t* __restrict__ out) {
    const int row = blockIdx.x * 4 + (threadIdx.x >> 6), lane = threadIdx.x & 63;
    const float* xr = x + (size_t)row * DM; float v[16]; float s = 0.f;
#pragma unroll
    for (int j = 0; j < 16; ++j) { v[j] = xr[lane + 64 * j]; s += v[j] * v[j]; }
    const float r = rsqrtf(wave_sum(s) * (1.f / DM) + EPS);
#pragma unroll
    for (int j = 0; j < 16; ++j) out[(size_t)row * DM + lane + 64 * j] = f2bf(v[j] * r * g[lane + 64 * j]);
}

__global__ void __launch_bounds__(256) k_rowss(const float* __restrict__ h, float* __restrict__ ss) {
    const int row = blockIdx.x * 4 + (threadIdx.x >> 6), lane = threadIdx.x & 63;
    const float* xr = h + (size_t)row * DM; float s = 0.f;
#pragma unroll
    for (int j = 0; j < 16; ++j) { float v = xr[lane + 64 * j]; s += v * v; }
    s = wave_sum(s);
    if (lane < 16) ss[(size_t)row * 16 + lane] = lane == 0 ? s : 0.f;
}
__device__ __forceinline__ float row_rstd(const float* ss, int row) {
    float s = 0.f;
#pragma unroll
    for (int i = 0; i < 16; ++i) s += ss[(size_t)row * 16 + i];
    return rsqrtf(s * (1.f / DM) + EPS);
}
__global__ void __launch_bounds__(256) k_final(float* __restrict__ out, const float* __restrict__ ss, const float* __restrict__ g) {
    const int row = blockIdx.x * 4 + (threadIdx.x >> 6), lane = threadIdx.x & 63;
    const float r = row_rstd(ss, row);
    float* xr = out + (size_t)row * DM;
#pragma unroll
    for (int j = 0; j < 16; ++j) xr[lane + 64 * j] = xr[lane + 64 * j] * r * g[lane + 64 * j];
}

enum { EPI_PROJ = 0, EPI_GLU = 1, EPI_OUT = 2, EPI_UP = 3, EPI_DOWN = 4 };
struct EpiArgs { bf16_t* obf; float* of32; const float* x; const float* vec; const bf16_t* zin; const float* ss; int ldo; };
template <int EPI> __device__ __forceinline__ void epi_elem(const EpiArgs& e, int row, int col, float acc) {
    if (EPI == EPI_PROJ) e.obf[(size_t)row * e.ldo + col] = f2bf(acc);
    else if (EPI == EPI_GLU) { const float z = bf2f(e.zin[(size_t)row * SSMW + col]); const float s = 1.f / (1.f + __expf(-(acc + e.vec[col]))); e.obf[(size_t)row * e.ldo + SSMW + col] = f2bf(z * s); }
    else if (EPI == EPI_OUT) { const float h = e.x[(size_t)row * DM + col] + acc; e.of32[(size_t)row * DM + col] = h; e.obf[(size_t)row * DM + col] = f2bf(h); }
    else if (EPI == EPI_UP) { float v = acc * row_rstd(e.ss, row); v = fmaxf(v, 0.f); e.obf[(size_t)row * e.ldo + col] = f2bf(v * v); }
    else if (EPI == EPI_DOWN) { e.of32[(size_t)row * DM + col] += acc; }
}
template <int EPI> __global__ void __launch_bounds__(256) k_gemm_naive(const bf16_t* __restrict__ A, const bf16_t* __restrict__ Bt, int K, EpiArgs e) {
    __shared__ float As[64][33], Bs[64][33];
    const int tid = threadIdx.x, tx = tid & 15, ty = tid >> 4, m0 = blockIdx.y * 64, n0 = blockIdx.x * 64;
    float acc[4][4] = {};
    for (int k0 = 0; k0 < K; k0 += 32) {
        for (int i = tid; i < 64 * 32; i += 256) { const int r = i >> 5, c = i & 31; As[r][c] = bf2f(A[(size_t)(m0 + r) * K + k0 + c]); Bs[r][c] = bf2f(Bt[(size_t)(n0 + r) * K + k0 + c]); }
        __syncthreads();
#pragma unroll 8
        for (int k = 0; k < 32; ++k) { float a[4], b[4];
#pragma unroll
            for (int i = 0; i < 4; ++i) { a[i] = As[ty * 4 + i][k]; b[i] = Bs[tx * 4 + i][k]; }
#pragma unroll
            for (int i = 0; i < 4; ++i)
#pragma unroll
                for (int j = 0; j < 4; ++j) acc[i][j] = fmaf(a[i], b[j], acc[i][j]); }
        __syncthreads();
    }
#pragma unroll
    for (int i = 0; i < 4; ++i)
#pragma unroll
        for (int j = 0; j < 4; ++j) epi_elem<EPI>(e, m0 + ty * 4 + i, n0 + tx * 4 + j, acc[i][j]);
}

__global__ void __launch_bounds__(256) k_attn_naive(const bf16_t* __restrict__ proj, bf16_t* __restrict__ mix, const float* __restrict__ lq1, const float* __restrict__ lk1,
                                                    const float* __restrict__ lq2, const float* __restrict__ lk2, const float* __restrict__ subg) {
    __shared__ float abuf[4][SEQ];
    const int w = threadIdx.x >> 6, lane = threadIdx.x & 63;
    const int i = blockIdx.x * 4 + w, h = blockIdx.y, b = blockIdx.z;
    float* a = abuf[w];
    float d1 = 0.f, d2 = 0.f;
    d1 = wave_sum(lq1[lane] * lk1[lane]); d2 = wave_sum(lq2[lane] * lk2[lane]);
    const float lam = expf(d1) - expf(d2) + LAMBDA_INIT;
    const float slope = exp2f(-8.0f * (float)(h + 1) / (float)NH);
    const size_t rowq = (size_t)(b * SEQ + i) * NPROJ;
    for (int c = 0; c < 2; ++c) {
        float q[64];
#pragma unroll
        for (int d = 0; d < 64; ++d) q[d] = bf2f(proj[rowq + h * 128 + c * 64 + d]);
        float sc[32]; float mx = -3.0e38f;
#pragma unroll
        for (int t = 0; t < 32; ++t) { const int j = lane + 64 * t; const bf16_t* kr = proj + (size_t)(b * SEQ + j) * NPROJ + 512 + h * 128 + c * 64;
            float s = 0.f;
#pragma unroll
            for (int d = 0; d < 64; ++d) s = fmaf(q[d], bf2f(kr[d]), s);
            s = s * 0.125f - slope * fabsf((float)(i - j)); sc[t] = s; mx = fmaxf(mx, s); }
        mx = wave_max(mx); float l = 0.f;
#pragma unroll
        for (int t = 0; t < 32; ++t) { sc[t] = expf(sc[t] - mx); l += sc[t]; }
        l = wave_sum(l); const float il = 1.f / l;
#pragma unroll
        for (int t = 0; t < 32; ++t) { const int j = lane + 64 * t; if (c == 0) a[j] = sc[t] * il; else a[j] -= lam * sc[t] * il; }
    }
    __syncthreads();
    float o0 = 0.f, o1 = 0.f;
    for (int j = 0; j < SEQ; ++j) { const bf16_t* vr = proj + (size_t)(b * SEQ + j) * NPROJ + 1024 + h * 128; const float aj = a[j]; o0 = fmaf(aj, bf2f(vr[lane]), o0); o1 = fmaf(aj, bf2f(vr[64 + lane]), o1); }
    const float ms = wave_sum(o0 * o0 + o1 * o1) * (1.f / 128.f); const float r = rsqrtf(ms + EPS) * (1.f - LAMBDA_INIT);
    bf16_t* orow = mix + (size_t)(b * SEQ + i) * DM + h * 128;
    orow[lane] = f2bf(o0 * r * subg[lane]); orow[64 + lane] = f2bf(o1 * r * subg[64 + lane]);
}

__global__ void __launch_bounds__(64) k_ssm_naive(const bf16_t* __restrict__ proj, float* __restrict__ Y, const float* __restrict__ lam_re, const float* __restrict__ lam_im, const float* __restrict__ log_dt,
                                                  const float* __restrict__ b_re, const float* __restrict__ b_im, const float* __restrict__ c_re, const float* __restrict__ c_im) {
    __shared__ float xs[2][64]; __shared__ float cs[2][64][17];
    const int g = blockIdx.x, b = blockIdx.y, p = threadIdx.x;
    for (int dir = 0; dir < 2; ++dir) {
        const int pg = (dir * NG + g);
        const float dt = expf(log_dt[pg]), lr = lam_re[pg * NP + p], li = lam_im[pg * NP + p];
        const float mag = expf(lr * dt), ang = li * dt, ar = mag * cosf(ang), ai = mag * sinf(ang), nr = ar - 1.f, den = lr * lr + li * li;
        const float cr = (nr * lr + ai * li) / den, ci = (ai * lr - nr * li) / den;
        float bbr[16], bbi[16];
#pragma unroll
        for (int h = 0; h < 16; ++h) { const float br = b_re[(size_t)(pg * NP + p) * GC + h], bi = b_im[(size_t)(pg * NP + p) * GC + h]; bbr[h] = cr * br - ci * bi; bbi[h] = cr * bi + ci * br; }
        __syncthreads();
        for (int h = 0; h < 16; ++h) { cs[0][p][h] = c_re[(size_t)(pg * GC + h) * NP + p]; cs[1][p][h] = c_im[(size_t)(pg * GC + h) * NP + p]; }
        __syncthreads();
        float xr = 0.f, xi = 0.f;
        for (int s = 0; s < SEQ; ++s) {
            const int t = dir == 0 ? s : SEQ - 1 - s;
            const bf16_t* ur = proj + (size_t)(b * SEQ + t) * NPROJ + 1536 + g * GC;
            float bur = 0.f, bui = 0.f;
#pragma unroll
            for (int h = 0; h < 16; ++h) { const float u = bf2f(ur[h]); bur = fmaf(bbr[h], u, bur); bui = fmaf(bbi[h], u, bui); }
            const float nxr = ar * xr - ai * xi + bur, nxi = ar * xi + ai * xr + bui; xr = nxr; xi = nxi;
            xs[0][p] = xr; xs[1][p] = xi;
            __syncthreads();
            if (p < 16) { float y = 0.f;
                for (int q = 0; q < 64; ++q) y += cs[0][q][p] * xs[0][q] - cs[1][q][p] * xs[1][q];
                float* yp = Y + (size_t)(b * SEQ + t) * SSMW + g * GC + p; if (dir == 0) *yp = y; else *yp += y; }
            __syncthreads();
        }
    }
}
__global__ void __launch_bounds__(256) k_ssm_post(const float* __restrict__ Y, const bf16_t* __restrict__ proj, const float* __restrict__ dskip, bf16_t* __restrict__ Z) {
    const size_t idx = (size_t)blockIdx.x * 256 + threadIdx.x; const int row = (int)(idx / SSMW), ch = (int)(idx % SSMW);
    const float u = bf2f(proj[(size_t)row * NPROJ + 1536 + ch]); const float y = Y[idx] + dskip[ch] * u;
    Z[idx] = f2bf(0.5f * y * (1.f + erff(y * 0.70710678118654752f)));
}

extern "C" void kernel_launch(void* const* d_in, const int* in_sizes, int n_in, void* d_out, int out_size, void* d_ws, size_t ws_size, hipStream_t stream) {
    (void)in_sizes; (void)n_in; (void)out_size; (void)ws_size;
    const float* x = (const float*)d_in[0]; const float* g1 = (const float*)d_in[1]; const float* w_in = (const float*)d_in[2];
    const float* lq1 = (const float*)d_in[3]; const float* lk1 = (const float*)d_in[4]; const float* lq2 = (const float*)d_in[5]; const float* lk2 = (const float*)d_in[6];
    const float* subg = (const float*)d_in[7]; const float* s_lre = (const float*)d_in[8]; const float* s_lim = (const float*)d_in[9]; const float* s_ldt = (const float*)d_in[10];
    const float* s_bre = (const float*)d_in[11]; const float* s_bim = (const float*)d_in[12]; const float* s_cre = (const float*)d_in[13]; const float* s_cim = (const float*)d_in[14];
    const float* s_d = (const float*)d_in[15]; const float* w_glu = (const float*)d_in[16]; const float* b_glu = (const float*)d_in[17]; const float* w_out = (const float*)d_in[18];
    const float* g2 = (const float*)d_in[19]; const float* w1 = (const float*)d_in[20]; const float* w2 = (const float*)d_in[21]; const float* gf = (const float*)d_in[22];
    float* out = (float*)d_out; unsigned char* ws = (unsigned char*)d_ws;
    bf16_t* WIN = (bf16_t*)(ws + WS_WIN); bf16_t* WGLU = (bf16_t*)(ws + WS_WGLU); bf16_t* WOUT = (bf16_t*)(ws + WS_WOUT); bf16_t* W1T = (bf16_t*)(ws + WS_W1); bf16_t* W2T = (bf16_t*)(ws + WS_W2);
    float* SS1 = (float*)(ws + WS_SS1); float* SS2 = (float*)(ws + WS_SS2);
    bf16_t* XN = (bf16_t*)(ws + WS_XN); bf16_t* PROJ = (bf16_t*)(ws + WS_PROJ); bf16_t* MIX = (bf16_t*)(ws + WS_MIX); bf16_t* Z = (bf16_t*)(ws + WS_Z); bf16_t* H = (bf16_t*)(ws + WS_H); float* Y = (float*)(ws + WS_Y);

    k_transpose_w<<<dim3(NPROJ / 32, DM / 32), 256, 0, stream>>>(w_in, nullptr, WIN, DM, NPROJ);
    k_transpose_w<<<dim3(SSMW / 32, SSMW / 32), 256, 0, stream>>>(w_glu, nullptr, WGLU, SSMW, SSMW);
    k_transpose_w<<<dim3(DM / 32, DM / 32), 256, 0, stream>>>(w_out, nullptr, WOUT, DM, DM);
    k_transpose_w<<<dim3(FF / 32, DM / 32), 256, 0, stream>>>(w1, g2, W1T, DM, FF);
    k_transpose_w<<<dim3(DM / 32, FF / 32), 256, 0, stream>>>(w2, nullptr, W2T, FF, DM);
    k_rmsnorm_bf16<<<M_TOK / 4, 256, 0, stream>>>(x, g1, XN);
    { EpiArgs e{}; e.obf = PROJ; e.ldo = NPROJ; k_gemm_naive<EPI_PROJ><<<dim3(NPROJ / 64, M_TOK / 64), 256, 0, stream>>>(XN, WIN, DM, e); }
    k_attn_naive<<<dim3(SEQ / 4, NH, BATCH), 256, 0, stream>>>(PROJ, MIX, lq1, lk1, lq2, lk2, subg);
    k_ssm_naive<<<dim3(NG, BATCH), 64, 0, stream>>>(PROJ, Y, s_lre, s_lim, s_ldt, s_bre, s_bim, s_cre, s_cim);
    k_ssm_post<<<M_TOK * SSMW / 256, 256, 0, stream>>>(Y, PROJ, s_d, Z);
    { EpiArgs e{}; e.obf = MIX; e.ldo = DM; e.zin = Z; e.vec = b_glu; k_gemm_naive<EPI_GLU><<<dim3(SSMW / 64, M_TOK / 64), 256, 0, stream>>>(Z, WGLU, SSMW, e); }
    { EpiArgs e{}; e.obf = XN; e.of32 = out; e.x = x; e.ldo = DM; k_gemm_naive<EPI_OUT><<<dim3(DM / 64, M_TOK / 64), 256, 0, stream>>>(MIX, WOUT, DM, e); }
    k_rowss<<<M_TOK / 4, 256, 0, stream>>>(out, SS1);
    { EpiArgs e{}; e.obf = H; e.ldo = FF; e.ss = SS1; k_gemm_naive<EPI_UP><<<dim3(FF / 64, M_TOK / 64), 256, 0, stream>>>(XN, W1T, DM, e); }
    { EpiArgs e{}; e.of32 = out; k_gemm_naive<EPI_DOWN><<<dim3(DM / 64, M_TOK / 64), 256, 0, stream>>>(H, W2T, FF, e); }
    k_rowss<<<M_TOK / 4, 256, 0, stream>>>(out, SS2);
    k_final<<<M_TOK / 4, 256, 0, stream>>>(out, SS2, gf);
}
```

```cpp
#include <hip/hip_runtime.h>
#include <cstdio>
#include <cstdint>
#include <cmath>

typedef unsigned short bf16_t;

constexpr int BATCH = 8, SEQ = 2048, DM = 1024, M_TOK = BATCH * SEQ;
constexpr int NPROJ = 2048, FF = 4096, NH = 4, VD = 128, QKD = 64, SSMW = 512, NG = 32, GC = 16, NP = 64;
constexpr float EPS = 1e-6f;
constexpr float LAMBDA_INIT = 0.2f;

constexpr size_t MiB = 1u << 20;
constexpr size_t WS_WIN = 2 * MiB, WS_WGLU = 6 * MiB, WS_WOUT = 7 * MiB, WS_W1 = 10 * MiB, WS_W2 = 18 * MiB;
constexpr size_t WS_SS1 = 36 * MiB, WS_SS2 = 37 * MiB;
constexpr size_t WS_XN = 40 * MiB, WS_PROJ = 72 * MiB, WS_MIX = 136 * MiB, WS_Z = 168 * MiB, WS_H = 72 * MiB, WS_Y = 200 * MiB;

__device__ __forceinline__ float bf2f(bf16_t v) { return __uint_as_float((unsigned)v << 16); }
__device__ __forceinline__ bf16_t f2bf(float f) { unsigned u = __float_as_uint(f); return (bf16_t)((u + 0x7fffu + ((u >> 16) & 1u)) >> 16); }
__device__ __forceinline__ float wave_sum(float v) {
#pragma unroll
    for (int o = 1; o < 64; o <<= 1) v += __shfl_xor(v, o);
    return v;
}
__device__ __forceinline__ float wave_max(float v) {
#pragma unroll
    for (int o = 1; o < 64; o <<= 1) v = fmaxf(v, __shfl_xor(v, o));
    return v;
}

namespace pg8 {
#define PG8_LAS __attribute__((address_space(3)))
typedef unsigned short bf16_t;
typedef short bf16x8 __attribute__((ext_vector_type(8)));
typedef float f32x4 __attribute__((ext_vector_type(4)));
typedef unsigned u32x4 __attribute__((ext_vector_type(4)));
constexpr int BM = 256, BK = 64, HALF = 128, HTB = HALF * BK * 2  , STAGE_BYTES = 8 * HTB, NXCD = 8, WGM = 8;

__host__ __device__ __forceinline__ int lds_byte(int r, int c) { const int st = (r >> 4) * 2 + (c >> 5), rr = r & 15, cc = c & 31, ob = rr * 64 + cc * 2; return st * 1024 + (ob ^ (((ob >> 9) & 1) << 5)); }
__host__ __device__ __forceinline__ void stage_rc(int b, int& R, int& C) { const int st = b / 1024, sb = b % 1024, swz = sb ^ (((sb >> 9) & 1) << 5); R = (st >> 1) * 16 + swz / 64; C = (st & 1) * 32 + (swz % 64) / 2; }
__host__ __device__ __forceinline__ int perm32(int rho) { const int n = rho >> 4, i = rho & 15; return 8 * (i >> 2) + 4 * n + (i & 3); }

struct Unit { int pm, pn; };
struct Gemm { const bf16_t* A; const bf16_t* Bt; int M, N, K; };

struct StaticOrder {
    int nM, nN, nwg, G, c;
    __host__ __device__ void init(int M, int N, int G_, int c_) { nM = M / BM; nN = N / BM; nwg = nM * nN; G = G_; c = c_; }
    __host__ __device__ bool next(int i, Unit& u) const {
        const long L = (long)i * G + c; if (L >= nwg) return false;
        int wgid = (int)L; { const int q = nwg / NXCD, r = nwg % NXCD, xcd = wgid % NXCD, off = wgid / NXCD; wgid = (xcd < r ? xcd * (q + 1) : r * (q + 1) + (xcd - r) * q) + off; }
        const int nig = WGM * nN, gid = wgid / nig, fm = gid * WGM, gsz = (nM - fm) < WGM ? (nM - fm) : WGM;
        u.pm = fm + ((wgid % nig) % gsz); u.pn = (wgid % nig) / gsz; return true;
    }
    __device__ __forceinline__ void a_ready(const Unit&) const {}
    __device__ __forceinline__ void done(const Unit&) const {}
};

__device__ __forceinline__ unsigned cvt_pk_bf16(float lo, float hi) { unsigned r; asm volatile("v_cvt_pk_bf16_f32 %0, %1, %2" : "=v"(r) : "v"(lo), "v"(hi)); return r; }
typedef float f32x2 __attribute__((ext_vector_type(2)));
__device__ __forceinline__ f32x2 gelu_pk(f32x2 v) {
    const f32x2 av = __builtin_elementwise_abs(v), d = av * 0.2316418882f + 1.0f;
    f32x2 t; t.x = __builtin_amdgcn_rcpf(d.x); t.y = __builtin_amdgcn_rcpf(d.y);
    f32x2 q = t * 0.5307027145f + (-0.7265760135f); q = q * t + 0.7107068705f; q = q * t + (-0.142248368f); q = q * t + 0.127414796f; q = q * t;
    const f32x2 s = (v * v) * (-0.72134752044f);
    f32x2 e; e.x = __builtin_amdgcn_exp2f(s.x); e.y = __builtin_amdgcn_exp2f(s.y);
    const f32x2 m = v * (q * e), r = v - m;
    f32x2 o; o.x = v.x < 0.f ? m.x : r.x; o.y = v.y < 0.f ? m.y : r.y; return o;
}
typedef unsigned u32x2 __attribute__((ext_vector_type(2)));
constexpr float RMS_EPS = 1e-6f;
__device__ __forceinline__ float rstd16(const float* ss, int row) {
    const f32x4* p = (const f32x4*)(ss + (size_t)row * 16); const f32x4 a = p[0], b = p[1], c = p[2], d = p[3];
    const float s = ((a[0] + a[1]) + (a[2] + a[3])) + ((b[0] + b[1]) + (b[2] + b[3])) + ((c[0] + c[1]) + (c[2] + c[3])) + ((d[0] + d[1]) + (d[2] + d[3]));
    return __builtin_amdgcn_rsqf(s * (1.0f / 1024.0f) + RMS_EPS);
}
struct EpiProj {
    static constexpr bool PERM = true, AFTER_DRAIN = false;
    bf16_t* O; int ldc;
    __device__ __forceinline__ void operator()(const f32x4 (&acc)[2][2][4][2], const Unit& u, int wr, int wc, int fr, int fq) const {
        const int row0 = u.pm * BM + wr * 64 + fr, col0 = u.pn * BM + wc * 32 + 8 * fq;
#pragma unroll
        for (int ai = 0; ai < 2; ++ai)
#pragma unroll
            for (int m = 0; m < 4; ++m) { bf16_t* rowp = O + (size_t)(row0 + ai * HALF + m * 16) * ldc + col0;
#pragma unroll
                for (int bj = 0; bj < 2; ++bj) { const f32x4 v0 = acc[ai][bj][m][0], v1 = acc[ai][bj][m][1];
                    u32x4 w; w.x = cvt_pk_bf16(v0[0], v0[1]); w.y = cvt_pk_bf16(v0[2], v0[3]); w.z = cvt_pk_bf16(v1[0], v1[1]); w.w = cvt_pk_bf16(v1[2], v1[3]);
                    *(u32x4*)(rowp + bj * HALF) = w; } }
    }
};
struct EpiGlu {
    static constexpr bool PERM = true, AFTER_DRAIN = false;
    const bf16_t* Z; const float* bias; bf16_t* O;
    __device__ __forceinline__ void operator()(const f32x4 (&acc)[2][2][4][2], const Unit& u, int wr, int wc, int fr, int fq) const {
        const int row0 = u.pm * BM + wr * 64 + fr, col0 = u.pn * BM + wc * 32 + 8 * fq;
        f32x4 bv[2][2];
#pragma unroll
        for (int bj = 0; bj < 2; ++bj)
#pragma unroll
            for (int n = 0; n < 2; ++n) bv[bj][n] = *(const f32x4*)(bias + col0 + bj * HALF + 4 * n);
#pragma unroll
        for (int ai = 0; ai < 2; ++ai)
#pragma unroll
            for (int m = 0; m < 4; ++m) { const size_t row = (size_t)(row0 + ai * HALF + m * 16);
#pragma unroll
                for (int bj = 0; bj < 2; ++bj) { const u32x4 zz = *(const u32x4*)(Z + row * 512 + col0 + bj * HALF);
                    float z[8]; z[0] = __uint_as_float(zz.x << 16); z[1] = __uint_as_float(zz.x & 0xffff0000u); z[2] = __uint_as_float(zz.y << 16); z[3] = __uint_as_float(zz.y & 0xffff0000u);
                    z[4] = __uint_as_float(zz.z << 16); z[5] = __uint_as_float(zz.z & 0xffff0000u); z[6] = __uint_as_float(zz.w << 16); z[7] = __uint_as_float(zz.w & 0xffff0000u);
                    float o[8];
#pragma unroll
                    for (int n = 0; n < 2; ++n)
#pragma unroll
                        for (int i = 0; i < 4; ++i) { const float t = acc[ai][bj][m][n][i] + bv[bj][n][i]; const float s = __builtin_amdgcn_rcpf(1.0f + __builtin_amdgcn_exp2f(-1.4426950408889634f * t)); o[4 * n + i] = z[4 * n + i] * s; }
                    u32x4 w; w.x = cvt_pk_bf16(o[0], o[1]); w.y = cvt_pk_bf16(o[2], o[3]); w.z = cvt_pk_bf16(o[4], o[5]); w.w = cvt_pk_bf16(o[6], o[7]);
                    *(u32x4*)(O + row * 1024 + 512 + col0 + bj * HALF) = w; } }
    }
};
template <bool WRITE_BF> struct EpiResid {
    static constexpr bool PERM = false, AFTER_DRAIN = false;
    const float* base; float* out; bf16_t* hb; float* ss;
    __device__ __forceinline__ void operator()(const f32x4 (&acc)[2][2][4][2], const Unit& u, int wr, int wc, int fr, int fq) const {
        const int row0 = u.pm * BM + wr * 64 + fr, col0 = u.pn * BM + wc * 32 + 4 * fq;
#pragma unroll
        for (int ai = 0; ai < 2; ++ai)
#pragma unroll
            for (int m = 0; m < 4; ++m) { const int row = row0 + ai * HALF + m * 16; const size_t off = (size_t)row * 1024 + col0; float s = 0.f;
#pragma unroll
                for (int bj = 0; bj < 2; ++bj)
#pragma unroll
                    for (int n = 0; n < 2; ++n) { const f32x4 h = *(const f32x4*)(base + off + bj * HALF + n * 16) + acc[ai][bj][m][n];
                        *(f32x4*)(out + off + bj * HALF + n * 16) = h; s += (h[0] * h[0] + h[1] * h[1]) + (h[2] * h[2] + h[3] * h[3]);
                        if (WRITE_BF) { u32x2 w; w.x = cvt_pk_bf16(h[0], h[1]); w.y = cvt_pk_bf16(h[2], h[3]); *(u32x2*)(hb + off + bj * HALF + n * 16) = w; } }
                s += __shfl_xor(s, 16); s += __shfl_xor(s, 32);
                if (fq == 0) ss[(size_t)row * 16 + u.pn * 4 + wc] = s; }
    }
};
struct EpiUp {
    static constexpr bool PERM = true, AFTER_DRAIN = false;
    bf16_t* O; int ldc; const float* ss;
    __device__ __forceinline__ void operator()(const f32x4 (&acc)[2][2][4][2], const Unit& u, int wr, int wc, int fr, int fq) const {
        const int row0 = u.pm * BM + wr * 64 + fr, col0 = u.pn * BM + wc * 32 + 8 * fq;
#pragma unroll
        for (int ai = 0; ai < 2; ++ai)
#pragma unroll
            for (int m = 0; m < 4; ++m) { const int row = row0 + ai * HALF + m * 16; const float r = rstd16(ss, row); bf16_t* rowp = O + (size_t)row * ldc + col0;
#pragma unroll
                for (int bj = 0; bj < 2; ++bj) { f32x4 v0 = acc[ai][bj][m][0] * r, v1 = acc[ai][bj][m][1] * r;
#pragma unroll
                    for (int i = 0; i < 4; ++i) { const float a = fmaxf(v0[i], 0.f), b = fmaxf(v1[i], 0.f); v0[i] = a * a; v1[i] = b * b; }
                    u32x4 w; w.x = cvt_pk_bf16(v0[0], v0[1]); w.y = cvt_pk_bf16(v0[2], v0[3]); w.z = cvt_pk_bf16(v1[0], v1[1]); w.w = cvt_pk_bf16(v1[2], v1[3]);
                    *(u32x4*)(rowp + bj * HALF) = w; } }
    }
};
template <class Epi, class Sched, bool ALIGN_EPI = false, bool SP2 = false>
__device__ __forceinline__ void gemm_phase(PG8_LAS unsigned char* lds, const Gemm g, const Sched& S, const Epi& E) {
    const int tid = threadIdx.x, wid = __builtin_amdgcn_readfirstlane(tid >> 6), lane = tid & 63, wr = wid >> 2, wc = wid & 3, fr = lane & 15, fq = lane >> 4;
    const int K = g.K, nt = K / BK;
    unsigned voffA[2], voffB[2];
#pragma unroll
    for (int i = 0; i < 2; ++i) { int R, C; stage_rc(tid * 16 + i * 8192, R, C); const int Rb = Epi::PERM ? ((R & ~31) + perm32(R & 31)) : R;
        voffA[i] = (unsigned)(R * K + C) * 2u; voffB[i] = (unsigned)(Rb * K + C) * 2u; }
    const size_t kstep = (size_t)(BK * 2);
    const size_t hstep = (size_t)HALF * K * 2;
    const size_t tstep = 2 * hstep;
    const unsigned ldsw = (unsigned)wid * 1024u;
    const int aoff = lds_byte(wr * 64 + fr, fq * 8), boff = lds_byte(wc * 32 + fr, fq * 8);
#define PG8_SA(b, h) (((b) * 2 + (h)) * HTB)
#define PG8_SB(b, h) ((4 + (b) * 2 + (h)) * HTB)
#define PG8_STAGE(bufoff, gbase, voff) do { _Pragma("unroll") for (int _i = 0; _i < 2; ++_i) \
        __builtin_amdgcn_global_load_lds((const unsigned*)((const char*)(gbase) + (voff)[_i]), (PG8_LAS unsigned*)(lds + (bufoff) + ldsw + _i * 8192), 16, 0, 0); } while (0)
#define PG8_LDA(dst, b, h) do { _Pragma("unroll") for (int m = 0; m < 4; ++m) _Pragma("unroll") for (int k = 0; k < 2; ++k) dst[m][k] = *(const PG8_LAS bf16x8*)(lds + PG8_SA(b, h) + aoff + m * 2048 + k * 1024); } while (0)
#define PG8_LDB(dst, b, h) do { _Pragma("unroll") for (int n = 0; n < 2; ++n) _Pragma("unroll") for (int k = 0; k < 2; ++k) dst[n][k] = *(const PG8_LAS bf16x8*)(lds + PG8_SB(b, h) + boff + n * 2048 + k * 1024); } while (0)
#define PG8_MMA(ai, bj, At, Bt) do { __builtin_amdgcn_s_setprio(1); _Pragma("unroll") for (int m = 0; m < 4; ++m) _Pragma("unroll") for (int n = 0; n < 2; ++n) _Pragma("unroll") for (int k = 0; k < 2; ++k) \
        acc[ai][bj][m][n] = __builtin_amdgcn_mfma_f32_16x16x32_bf16(Bt[n][k], At[m][k], acc[ai][bj][m][n], 0, 0, 0); __builtin_amdgcn_s_setprio(0); } while (0)
#define PG8_WAIT_V(n) asm volatile("s_waitcnt vmcnt(" #n ")" ::: "memory")
#define PG8_WAIT_L(n) asm volatile("s_waitcnt lgkmcnt(" #n ")" ::: "memory")
#define PG8_BAR __builtin_amdgcn_s_barrier()
#define PG8_SCHED __builtin_amdgcn_sched_barrier(0)
    Unit cur, nxt; int ui = 0;
    if (!S.next(0, cur)) return;
    f32x4 acc[2][2][4][2];
#pragma unroll
    for (int a = 0; a < 2; ++a)
#pragma unroll
        for (int b = 0; b < 2; ++b)
#pragma unroll
            for (int m = 0; m < 4; ++m)
#pragma unroll
                for (int n = 0; n < 2; ++n) acc[a][b][m][n] = (f32x4){0.f, 0.f, 0.f, 0.f};
    bf16x8 At[4][2], B0[2][2], B1[2][2];
    const char* cA = (const char*)g.A + (size_t)cur.pm * tstep; const char* cB = (const char*)g.Bt + (size_t)cur.pn * tstep;
    S.a_ready(cur);
    if constexpr (SP2) {
        PG8_STAGE(PG8_SB(0, 0), cB, voffB); PG8_STAGE(PG8_SB(0, 1), cB + hstep, voffB); PG8_STAGE(PG8_SA(0, 0), cA, voffA); PG8_STAGE(PG8_SA(0, 1), cA + hstep, voffA);
        if (wr == 1) PG8_BAR;
        PG8_WAIT_V(2); PG8_BAR;
        PG8_STAGE(PG8_SB(1, 0), cB + kstep, voffB); PG8_STAGE(PG8_SA(1, 0), cA + kstep, voffA); PG8_STAGE(PG8_SB(1, 1), cB + hstep + kstep, voffB);
        PG8_WAIT_V(6); PG8_BAR;
    } else {
        PG8_STAGE(PG8_SB(0, 0), cB, voffB); PG8_STAGE(PG8_SA(0, 0), cA, voffA); PG8_STAGE(PG8_SB(0, 1), cB + hstep, voffB); PG8_STAGE(PG8_SA(0, 1), cA + hstep, voffA);
        if (wr == 1) PG8_BAR;
        PG8_WAIT_V(4); PG8_BAR;
        PG8_STAGE(PG8_SB(1, 0), cB + kstep, voffB); PG8_STAGE(PG8_SA(1, 0), cA + kstep, voffA); PG8_STAGE(PG8_SB(1, 1), cB + hstep + kstep, voffB);
        PG8_WAIT_V(6); PG8_BAR;
    }
    for (;;) {
        const bool has_next = S.next(ui + 1, nxt);
        const char* nA = has_next ? (const char*)g.A + (size_t)nxt.pm * tstep : cA; const char* nB = has_next ? (const char*)g.Bt + (size_t)nxt.pn * tstep : cB;
        for (int t = 0; t < nt; t += 2) {
            const bool last = (t == nt - 2);
            const char* a1 = cA + (size_t)(t + 1) * kstep;
            const char* a2 = last ? nA : cA + (size_t)(t + 2) * kstep; const char* b2 = last ? nB : cB + (size_t)(t + 2) * kstep;
            const char* a3 = a2 + kstep; const char* b3 = b2 + kstep;
            if (last && has_next) S.a_ready(nxt);
            if constexpr (SP2) {
            PG8_LDB(B0, 0, 0); PG8_LDB(B1, 0, 1); PG8_SCHED; PG8_LDA(At, 0, 0); PG8_STAGE(PG8_SA(1, 1), a1 + hstep, voffA);
            PG8_WAIT_V(8); PG8_WAIT_L(0); PG8_BAR; PG8_MMA(0, 0, At, B0); PG8_MMA(0, 1, At, B1); PG8_BAR; PG8_SCHED;
            PG8_LDA(At, 0, 1); PG8_STAGE(PG8_SB(0, 0), b2, voffB); PG8_STAGE(PG8_SB(0, 1), b2 + hstep, voffB); PG8_STAGE(PG8_SA(0, 0), a2, voffA);
            PG8_WAIT_V(8); PG8_WAIT_L(0); PG8_BAR; PG8_MMA(1, 0, At, B0); PG8_MMA(1, 1, At, B1); PG8_BAR; PG8_SCHED;
            PG8_LDB(B0, 1, 0); PG8_LDB(B1, 1, 1); PG8_SCHED; PG8_LDA(At, 1, 0); PG8_STAGE(PG8_SA(0, 1), a2 + hstep, voffA);
            PG8_WAIT_V(8); PG8_WAIT_L(0); PG8_BAR; PG8_MMA(0, 0, At, B0); PG8_MMA(0, 1, At, B1); PG8_BAR; PG8_SCHED;
            PG8_LDA(At, 1, 1); PG8_STAGE(PG8_SB(1, 0), b3, voffB); PG8_STAGE(PG8_SB(1, 1), b3 + hstep, voffB); PG8_STAGE(PG8_SA(1, 0), a3, voffA);
            PG8_WAIT_V(8); PG8_WAIT_L(0); PG8_BAR; PG8_MMA(1, 0, At, B0); PG8_MMA(1, 1, At, B1); PG8_BAR; PG8_SCHED;
            } else {
            PG8_LDB(B0, 0, 0); PG8_SCHED; PG8_LDA(At, 0, 0); PG8_STAGE(PG8_SA(1, 1), a1 + hstep, voffA);
            PG8_WAIT_L(8); PG8_BAR; PG8_WAIT_L(0); PG8_MMA(0, 0, At, B0); PG8_BAR; PG8_SCHED;
            PG8_LDB(B1, 0, 1); PG8_STAGE(PG8_SB(0, 0), b2, voffB);
            PG8_BAR; PG8_WAIT_L(0); PG8_MMA(0, 1, At, B1); PG8_BAR;
            PG8_LDA(At, 0, 1); PG8_STAGE(PG8_SA(0, 0), a2, voffA);
            PG8_BAR; PG8_WAIT_L(0); PG8_MMA(1, 0, At, B0); PG8_BAR; PG8_SCHED;
            PG8_STAGE(PG8_SB(0, 1), b2 + hstep, voffB);
            PG8_WAIT_V(6); PG8_BAR; PG8_MMA(1, 1, At, B1); PG8_BAR;
            PG8_LDB(B0, 1, 0); PG8_SCHED; PG8_LDA(At, 1, 0); PG8_STAGE(PG8_SA(0, 1), a2 + hstep, voffA);
            PG8_WAIT_L(8); PG8_BAR; PG8_WAIT_L(0); PG8_MMA(0, 0, At, B0); PG8_BAR; PG8_SCHED;
            PG8_LDB(B1, 1, 1); PG8_STAGE(PG8_SB(1, 0), b3, voffB);
            PG8_BAR; PG8_WAIT_L(0); PG8_MMA(0, 1, At, B1); PG8_BAR;
            PG8_LDA(At, 1, 1); PG8_STAGE(PG8_SA(1, 0), a3, voffA);
            PG8_BAR; PG8_WAIT_L(0); PG8_MMA(1, 0, At, B0); PG8_BAR; PG8_SCHED;
            PG8_STAGE(PG8_SB(1, 1), b3 + hstep, voffB);
            PG8_WAIT_V(6); PG8_BAR; PG8_MMA(1, 1, At, B1); PG8_BAR;
            }
        }
        if constexpr (ALIGN_EPI) { if (wr == 0) PG8_BAR; }
        if constexpr (!Epi::AFTER_DRAIN) { E(acc, cur, wr, wc, fr, fq); S.done(cur); }
        if (!has_next) break;
#pragma unroll
        for (int a = 0; a < 2; ++a)
#pragma unroll
            for (int b = 0; b < 2; ++b)
#pragma unroll
                for (int m = 0; m < 4; ++m)
#pragma unroll
                    for (int n = 0; n < 2; ++n) acc[a][b][m][n] = (f32x4){0.f, 0.f, 0.f, 0.f};
        cur = nxt; cA = nA; cB = nB; ++ui;
        if constexpr (ALIGN_EPI) { if (wr == 1) PG8_BAR; }
    }
    PG8_WAIT_V(0);
    if constexpr (!ALIGN_EPI) { if (wr == 0) PG8_BAR; }
    PG8_BAR;
    if constexpr (Epi::AFTER_DRAIN) { E.fused(acc, cur, wr, wc, fr, fq, lds, wid, lane); S.done(cur); }
#undef PG8_SA
#undef PG8_SB
#undef PG8_STAGE
#undef PG8_LDA
#undef PG8_LDB
#undef PG8_MMA
#undef PG8_WAIT_V
#undef PG8_WAIT_L
#undef PG8_BAR
#undef PG8_SCHED
}
}
#define GAS __attribute__((address_space(1)))
#define LAS __attribute__((address_space(3)))
typedef unsigned v4u __attribute__((ext_vector_type(4)));
typedef float f32x4 __attribute__((ext_vector_type(4)));
typedef GAS unsigned gu32;
#define RLX_AGENT __ATOMIC_RELAXED, __HIP_MEMORY_SCOPE_AGENT
#define LDS_WAIT() asm volatile("s_waitcnt lgkmcnt(0)" ::: "memory")
#define VM_WAIT() asm volatile("s_waitcnt vmcnt(0)" ::: "memory")
constexpr int NWAVES = 8;
constexpr int RING_OFF = 0, RING_BYTES = 131072, LDSCTL_OFF = RING_BYTES, MISC_OFF = LDSCTL_OFF + 320, LDS_BYTES = 147456;
constexpr size_t WS_CTL = 0, CTL_ZERO_BYTES = 1 * MiB;
constexpr int CW_BAR = 4096;
#define XB_TMO      128
#define XB_XCNT(j)  (256  + 64 * (j))
#define XB_XSUB(j)  (1280 + 64 * (j))
#define XB_XGEN(j)  (2304 + 64 * (j))
#define XB_TOP      3328
#define XB_TOPGEN   3392
#define XCD_BAR_WORDS 3456
#define XB_SPIN_CAP (1u << 18)

__device__ __forceinline__ unsigned xb_ld(unsigned* p)              { return __hip_atomic_load(p, __ATOMIC_RELAXED, __HIP_MEMORY_SCOPE_AGENT); }
__device__ __forceinline__ unsigned xb_add(unsigned* p, unsigned v) { return __hip_atomic_fetch_add(p, v, __ATOMIC_RELAXED, __HIP_MEMORY_SCOPE_AGENT); }
__device__ __forceinline__ unsigned xb_xcc_id() { return (unsigned)__builtin_amdgcn_s_getreg((3 << 11) | 20) & 0xFu; }
#define XB_SPIN(cond, bar) do { unsigned _sp = 0; while (cond) { __builtin_amdgcn_s_sleep(1); \
    if ((++_sp & 255u) == 0u) { if (xb_ld(&(bar)[XB_TMO])) break; if (_sp > XB_SPIN_CAP) { atomicAdd(&(bar)[XB_TMO], 1u); break; } } } } while (0)

struct XcdBarrier {
    unsigned* bar; unsigned x;
    volatile LAS unsigned* st;
};

__device__ __forceinline__ XcdBarrier xcd_barrier_post(unsigned* bar, volatile LAS unsigned* st) {
    XcdBarrier b; b.bar = bar; b.x = xb_xcc_id(); b.st = st;
    if (threadIdx.x == 0) (void)xb_add(&bar[XB_XCNT(b.x)], 1u);
    return b;
}
__device__ __forceinline__ void xcd_barrier_complete(unsigned* bar, unsigned x, unsigned& nloc, unsigned& nx) {
    const unsigned G = gridDim.x * gridDim.y * gridDim.z;
    unsigned sum, cnt, mine, sp = 0u;
    for (;;) {
        sum = 0u; cnt = 0u; mine = 0u;
#pragma unroll
        for (unsigned j = 0; j < 16; ++j) { const unsigned c = xb_ld(&bar[XB_XCNT(j)]); sum += c; cnt += (c > 0u) ? 1u : 0u; mine = (j == x) ? c : mine; }
        if (sum == G) break;
        __builtin_amdgcn_s_sleep(1);
        if ((++sp & 255u) == 0u) { if (xb_ld(&bar[XB_TMO])) break; if (sp > XB_SPIN_CAP) { atomicAdd(&bar[XB_TMO], 1u); break; } }
    }
    nloc = mine > 0u ? mine : 1u; nx = cnt > 0u ? cnt : 1u;
}

__device__ __forceinline__ void xcd_barrier(const XcdBarrier& b) {
    asm volatile("s_waitcnt vmcnt(0)" ::: "memory");
    __syncthreads();
    if (threadIdx.x == 0) {
        unsigned* bar = b.bar;
        __builtin_amdgcn_s_waitcnt(0);
        unsigned nloc = b.st[0], nx = b.st[1];
        if (nloc == 0u) { xcd_barrier_complete(bar, b.x, nloc, nx); b.st[0] = nloc; b.st[1] = nx; }
        const unsigned old = xb_add(&bar[XB_XSUB(b.x)], 1u);
        const unsigned gen = old / nloc;
        if (old + 1u == (gen + 1u) * nloc) {
            __builtin_amdgcn_fence(__ATOMIC_RELEASE, "agent");
            asm volatile("s_waitcnt vmcnt(0)" ::: "memory");
            const unsigned og = xb_add(&bar[XB_TOP], 1u);
            const unsigned tg = og / nx;
            if (og + 1u == (tg + 1u) * nx) xb_add(&bar[XB_TOPGEN], 1u);
            else XB_SPIN(xb_ld(&bar[XB_TOPGEN]) == tg, bar);
            __builtin_amdgcn_fence(__ATOMIC_ACQUIRE, "agent");
            xb_add(&bar[XB_XGEN(b.x)], 1u);
            asm volatile("s_waitcnt vmcnt(0)" ::: "memory");
        } else {
            XB_SPIN(xb_ld(&bar[XB_XGEN(b.x)]) == gen, bar);
            __builtin_amdgcn_fence(__ATOMIC_ACQUIRE, "agent");
            asm volatile("s_waitcnt vmcnt(0)" ::: "memory");
        }
    }
    __syncthreads();
}
struct Args { const float* in[23]; float* out; unsigned char* ws; int ph_lo, ph_hi; };
__global__ void __launch_bounds__(NWAVES * 64, 2) mk_fwd(Args args) {
    extern __shared__ __attribute__((aligned(16))) unsigned char lds[];
    LAS unsigned char* L = (LAS unsigned char*)lds;
    volatile LAS unsigned* MISC = (volatile LAS unsigned*)(L + MISC_OFF);
    const int tid = threadIdx.x, lane = tid & 63, wave = __builtin_amdgcn_readfirstlane(tid >> 6);
    const int G = gridDim.x, bx = blockIdx.x;
    const int vcu = (G % 8 == 0) ? (bx % 8) * (G / 8) + bx / 8 : bx;
    unsigned char* ws = args.ws;
    gu32* ctl = (gu32*)(ws + WS_CTL);
    const float* x = args.in[0]; float* out = args.out;
    bf16_t* WIN = (bf16_t*)(ws + WS_WIN); bf16_t* WGLU = (bf16_t*)(ws + WS_WGLU); bf16_t* WOUT = (bf16_t*)(ws + WS_WOUT); bf16_t* W1T = (bf16_t*)(ws + WS_W1); bf16_t* W2T = (bf16_t*)(ws + WS_W2);
    float* SS1 = (float*)(ws + WS_SS1); float* SS2 = (float*)(ws + WS_SS2);
    bf16_t* XN = (bf16_t*)(ws + WS_XN); bf16_t* PROJ = (bf16_t*)(ws + WS_PROJ); bf16_t* MIX = (bf16_t*)(ws + WS_MIX); bf16_t* Z = (bf16_t*)(ws + WS_Z); bf16_t* H = (bf16_t*)(ws + WS_H);
    for (int u = tid; u < (LDS_BYTES - LDSCTL_OFF) / 4; u += NWAVES * 64) ((LAS unsigned*)(L + LDSCTL_OFF))[u] = 0u;
    __syncthreads();
    const int lo = args.ph_lo, hi = args.ph_hi;
    XcdBarrier bar; bar.bar = (unsigned*)(ctl + CW_BAR); bar.x = 0; bar.st = nullptr;
    if (hi - lo > 1) bar = xcd_barrier_post((unsigned*)(ctl + CW_BAR), MISC + 8);
#define IN(k) (lo <= (k) && (k) < hi)
#define BOTH(k) (IN(k) && IN((k) + 1))
#define GRID_BAR() xcd_barrier(bar)

    if (IN(1)) {
        pg8::Gemm g{XN, WIN, M_TOK, NPROJ, DM}; pg8::StaticOrder S; S.init(M_TOK, NPROJ, G, bx);
        pg8::EpiProj E{PROJ, NPROJ};
        pg8::gemm_phase<pg8::EpiProj, pg8::StaticOrder, true, true>(L + RING_OFF, g, S, E);
        if (BOTH(1)) GRID_BAR();
    }
    if (IN(3)) {
        pg8::Gemm g{Z, WGLU, M_TOK, SSMW, SSMW}; pg8::StaticOrder S; S.init(M_TOK, SSMW, G, bx);
        pg8::EpiGlu E{Z, args.in[17], MIX};
        pg8::gemm_phase<pg8::EpiGlu, pg8::StaticOrder, true, true>(L + RING_OFF, g, S, E);
        if (BOTH(3)) GRID_BAR();
    }
    if (IN(4)) {
        pg8::Gemm g{MIX, WOUT, M_TOK, DM, DM}; pg8::StaticOrder S; S.init(M_TOK, DM, G, bx);
        pg8::EpiResid<true> E{x, out, XN, SS1};
        pg8::gemm_phase<pg8::EpiResid<true>, pg8::StaticOrder, true, true>(L + RING_OFF, g, S, E);
        if (BOTH(4)) GRID_BAR();
    }
    if (IN(5)) {
        pg8::Gemm g{XN, W1T, M_TOK, FF, DM}; pg8::StaticOrder S; S.init(M_TOK, FF, G, bx);
        pg8::EpiUp E{H, FF, SS1};
        pg8::gemm_phase<pg8::EpiUp, pg8::StaticOrder, true, true>(L + RING_OFF, g, S, E);
        if (BOTH(5)) GRID_BAR();
    }
    if (IN(6)) {
        pg8::Gemm g{H, W2T, M_TOK, DM, FF}; pg8::StaticOrder S; S.init(M_TOK, DM, G, bx);
        pg8::EpiResid<false> E{out, out, nullptr, SS2};
        pg8::gemm_phase<pg8::EpiResid<false>, pg8::StaticOrder, true, true>(L + RING_OFF, g, S, E);
        if (BOTH(6)) GRID_BAR();
    }
    if (IN(7)) {
        const float* gf = args.in[22];
        const int gw = vcu * NWAVES + wave, NGW = G * NWAVES;
        for (int m = gw; m < M_TOK; m += NGW) {
            const float r = pg8::rstd16(SS2, m);
            GAS f32x4* o = (GAS f32x4*)(out + (size_t)m * DM) + lane; const GAS f32x4* gp = (const GAS f32x4*)gf + lane;
#pragma unroll
            for (int j = 0; j < 4; ++j) { f32x4 v = o[64 * j]; const f32x4 gg = gp[64 * j]; v = v * r * gg; o[64 * j] = v; }
        }
    }
#undef IN
#undef BOTH
#undef GRID_BAR
}
__global__ void __launch_bounds__(256) k_transpose_w(const float* __restrict__ W, const float* __restrict__ scale, bf16_t* __restrict__ WT, int K, int N) {
    __shared__ float t[32][33];
    const int k0 = blockIdx.y * 32, n0 = blockIdx.x * 32, tx = threadIdx.x & 31, ty = threadIdx.x >> 5;
    for (int i = ty; i < 32; i += 8) { float s = scale ? scale[k0 + i] : 1.f; t[i][tx] = W[(size_t)(k0 + i) * N + n0 + tx] * s; }
    __syncthreads();
    for (int i = ty; i < 32; i += 8) WT[(size_t)(n0 + i) * K + k0 + tx] = f2bf(t[tx][i]);
}

__global__ void __launch_bounds__(256) k_rmsnorm_bf16(const float* __restrict__ x, const float* __restrict__ g, bf16_t* __restrict__ out) {
    const int row = blockIdx.x * 4 + (threadIdx.x >> 6), lane = threadIdx.x & 63;
    const float* xr = x + (size_t)row * DM; float v[16]; float s = 0.f;
#pragma unroll
    for (int j = 0; j < 16; ++j) { v[j] = xr[lane + 64 * j]; s += v[j] * v[j]; }
    const float r = rsqrtf(wave_sum(s) * (1.f / DM) + EPS);
#pragma unroll
    for (int j = 0; j < 16; ++j) out[(size_t)row * DM + lane + 64 * j] = f2bf(v[j] * r * g[lane + 64 * j]);
}

__global__ void __launch_bounds__(256) k_rowss(const float* __restrict__ h, float* __restrict__ ss) {
    const int row = blockIdx.x * 4 + (threadIdx.x >> 6), lane = threadIdx.x & 63;
    const float* xr = h + (size_t)row * DM; float s = 0.f;
#pragma unroll
    for (int j = 0; j < 16; ++j) { float v = xr[lane + 64 * j]; s += v * v; }
    s = wave_sum(s);
    if (lane < 16) ss[(size_t)row * 16 + lane] = lane == 0 ? s : 0.f;
}
__device__ __forceinline__ float row_rstd(const float* ss, int row) {
    float s = 0.f;
#pragma unroll
    for (int i = 0; i < 16; ++i) s += ss[(size_t)row * 16 + i];
    return rsqrtf(s * (1.f / DM) + EPS);
}
__global__ void __launch_bounds__(256) k_final(float* __restrict__ out, const float* __restrict__ ss, const float* __restrict__ g) {
    const int row = blockIdx.x * 4 + (threadIdx.x >> 6), lane = threadIdx.x & 63;
    const float r = row_rstd(ss, row);
    float* xr = out + (size_t)row * DM;
#pragma unroll
    for (int j = 0; j < 16; ++j) xr[lane + 64 * j] = xr[lane + 64 * j] * r * g[lane + 64 * j];
}

enum { EPI_PROJ = 0, EPI_GLU = 1, EPI_OUT = 2, EPI_UP = 3, EPI_DOWN = 4 };
struct EpiArgs { bf16_t* obf; float* of32; const float* x; const float* vec; const bf16_t* zin; const float* ss; int ldo; };
template <int EPI> __device__ __forceinline__ void epi_elem(const EpiArgs& e, int row, int col, float acc) {
    if (EPI == EPI_PROJ) e.obf[(size_t)row * e.ldo + col] = f2bf(acc);
    else if (EPI == EPI_GLU) { const float z = bf2f(e.zin[(size_t)row * SSMW + col]); const float s = 1.f / (1.f + __expf(-(acc + e.vec[col]))); e.obf[(size_t)row * e.ldo + SSMW + col] = f2bf(z * s); }
    else if (EPI == EPI_OUT) { const float h = e.x[(size_t)row * DM + col] + acc; e.of32[(size_t)row * DM + col] = h; e.obf[(size_t)row * DM + col] = f2bf(h); }
    else if (EPI == EPI_UP) { float v = acc * row_rstd(e.ss, row); v = fmaxf(v, 0.f); e.obf[(size_t)row * e.ldo + col] = f2bf(v * v); }
    else if (EPI == EPI_DOWN) { e.of32[(size_t)row * DM + col] += acc; }
}
template <int EPI> __global__ void __launch_bounds__(256) k_gemm_naive(const bf16_t* __restrict__ A, const bf16_t* __restrict__ Bt, int K, EpiArgs e) {
    __shared__ float As[64][33], Bs[64][33];
    const int tid = threadIdx.x, tx = tid & 15, ty = tid >> 4, m0 = blockIdx.y * 64, n0 = blockIdx.x * 64;
    float acc[4][4] = {};
    for (int k0 = 0; k0 < K; k0 += 32) {
        for (int i = tid; i < 64 * 32; i += 256) { const int r = i >> 5, c = i & 31; As[r][c] = bf2f(A[(size_t)(m0 + r) * K + k0 + c]); Bs[r][c] = bf2f(Bt[(size_t)(n0 + r) * K + k0 + c]); }
        __syncthreads();
#pragma unroll 8
        for (int k = 0; k < 32; ++k) { float a[4], b[4];
#pragma unroll
            for (int i = 0; i < 4; ++i) { a[i] = As[ty * 4 + i][k]; b[i] = Bs[tx * 4 + i][k]; }
#pragma unroll
            for (int i = 0; i < 4; ++i)
#pragma unroll
                for (int j = 0; j < 4; ++j) acc[i][j] = fmaf(a[i], b[j], acc[i][j]); }
        __syncthreads();
    }
#pragma unroll
    for (int i = 0; i < 4; ++i)
#pragma unroll
        for (int j = 0; j < 4; ++j) epi_elem<EPI>(e, m0 + ty * 4 + i, n0 + tx * 4 + j, acc[i][j]);
}

__global__ void __launch_bounds__(256) k_attn_naive(const bf16_t* __restrict__ proj, bf16_t* __restrict__ mix, const float* __restrict__ lq1, const float* __restrict__ lk1,
                                                    const float* __restrict__ lq2, const float* __restrict__ lk2, const float* __restrict__ subg) {
    __shared__ float abuf[4][SEQ];
    const int w = threadIdx.x >> 6, lane = threadIdx.x & 63;
    const int i = blockIdx.x * 4 + w, h = blockIdx.y, b = blockIdx.z;
    float* a = abuf[w];
    float d1 = 0.f, d2 = 0.f;
    d1 = wave_sum(lq1[lane] * lk1[lane]); d2 = wave_sum(lq2[lane] * lk2[lane]);
    const float lam = expf(d1) - expf(d2) + LAMBDA_INIT;
    const float slope = exp2f(-8.0f * (float)(h + 1) / (float)NH);
    const size_t rowq = (size_t)(b * SEQ + i) * NPROJ;
    for (int c = 0; c < 2; ++c) {
        float q[64];
#pragma unroll
        for (int d = 0; d < 64; ++d) q[d] = bf2f(proj[rowq + h * 128 + c * 64 + d]);
        float sc[32]; float mx = -3.0e38f;
#pragma unroll
        for (int t = 0; t < 32; ++t) { const int j = lane + 64 * t; const bf16_t* kr = proj + (size_t)(b * SEQ + j) * NPROJ + 512 + h * 128 + c * 64;
            float s = 0.f;
#pragma unroll
            for (int d = 0; d < 64; ++d) s = fmaf(q[d], bf2f(kr[d]), s);
            s = s * 0.125f - slope * fabsf((float)(i - j)); sc[t] = s; mx = fmaxf(mx, s); }
        mx = wave_max(mx); float l = 0.f;
#pragma unroll
        for (int t = 0; t < 32; ++t) { sc[t] = expf(sc[t] - mx); l += sc[t]; }
        l = wave_sum(l); const float il = 1.f / l;
#pragma unroll
        for (int t = 0; t < 32; ++t) { const int j = lane + 64 * t; if (c == 0) a[j] = sc[t] * il; else a[j] -= lam * sc[t] * il; }
    }
    __syncthreads();
    float o0 = 0.f, o1 = 0.f;
    for (int j = 0; j < SEQ; ++j) { const bf16_t* vr = proj + (size_t)(b * SEQ + j) * NPROJ + 1024 + h * 128; const float aj = a[j]; o0 = fmaf(aj, bf2f(vr[lane]), o0); o1 = fmaf(aj, bf2f(vr[64 + lane]), o1); }
    const float ms = wave_sum(o0 * o0 + o1 * o1) * (1.f / 128.f); const float r = rsqrtf(ms + EPS) * (1.f - LAMBDA_INIT);
    bf16_t* orow = mix + (size_t)(b * SEQ + i) * DM + h * 128;
    orow[lane] = f2bf(o0 * r * subg[lane]); orow[64 + lane] = f2bf(o1 * r * subg[64 + lane]);
}

__global__ void __launch_bounds__(64) k_ssm_naive(const bf16_t* __restrict__ proj, float* __restrict__ Y, const float* __restrict__ lam_re, const float* __restrict__ lam_im, const float* __restrict__ log_dt,
                                                  const float* __restrict__ b_re, const float* __restrict__ b_im, const float* __restrict__ c_re, const float* __restrict__ c_im) {
    __shared__ float xs[2][64]; __shared__ float cs[2][64][17];
    const int g = blockIdx.x, b = blockIdx.y, p = threadIdx.x;
    for (int dir = 0; dir < 2; ++dir) {
        const int pg = (dir * NG + g);
        const float dt = expf(log_dt[pg]), lr = lam_re[pg * NP + p], li = lam_im[pg * NP + p];
        const float mag = expf(lr * dt), ang = li * dt, ar = mag * cosf(ang), ai = mag * sinf(ang), nr = ar - 1.f, den = lr * lr + li * li;
        const float cr = (nr * lr + ai * li) / den, ci = (ai * lr - nr * li) / den;
        float bbr[16], bbi[16];
#pragma unroll
        for (int h = 0; h < 16; ++h) { const float br = b_re[(size_t)(pg * NP + p) * GC + h], bi = b_im[(size_t)(pg * NP + p) * GC + h]; bbr[h] = cr * br - ci * bi; bbi[h] = cr * bi + ci * br; }
        __syncthreads();
        for (int h = 0; h < 16; ++h) { cs[0][p][h] = c_re[(size_t)(pg * GC + h) * NP + p]; cs[1][p][h] = c_im[(size_t)(pg * GC + h) * NP + p]; }
        __syncthreads();
        float xr = 0.f, xi = 0.f;
        for (int s = 0; s < SEQ; ++s) {
            const int t = dir == 0 ? s : SEQ - 1 - s;
            const bf16_t* ur = proj + (size_t)(b * SEQ + t) * NPROJ + 1536 + g * GC;
            float bur = 0.f, bui = 0.f;
#pragma unroll
            for (int h = 0; h < 16; ++h) { const float u = bf2f(ur[h]); bur = fmaf(bbr[h], u, bur); bui = fmaf(bbi[h], u, bui); }
            const float nxr = ar * xr - ai * xi + bur, nxi = ar * xi + ai * xr + bui; xr = nxr; xi = nxi;
            xs[0][p] = xr; xs[1][p] = xi;
            __syncthreads();
            if (p < 16) { float y = 0.f;
                for (int q = 0; q < 64; ++q) y += cs[0][q][p] * xs[0][q] - cs[1][q][p] * xs[1][q];
                float* yp = Y + (size_t)(b * SEQ + t) * SSMW + g * GC + p; if (dir == 0) *yp = y; else *yp += y; }
            __syncthreads();
        }
    }
}
__global__ void __launch_bounds__(256) k_ssm_post(const float* __restrict__ Y, const bf16_t* __restrict__ proj, const float* __restrict__ dskip, bf16_t* __restrict__ Z) {
    const size_t idx = (size_t)blockIdx.x * 256 + threadIdx.x; const int row = (int)(idx / SSMW), ch = (int)(idx % SSMW);
    const float u = bf2f(proj[(size_t)row * NPROJ + 1536 + ch]); const float y = Y[idx] + dskip[ch] * u;
    Z[idx] = f2bf(0.5f * y * (1.f + erff(y * 0.70710678118654752f)));
}

static void launch_mk(Args a, int lo, int hi, int grid, hipStream_t stream) {
    a.ph_lo = lo; a.ph_hi = hi;
    hipLaunchKernelGGL(mk_fwd, dim3(grid), dim3(NWAVES * 64), LDS_BYTES, stream, a);
}
extern "C" void kernel_launch(void* const* d_in, const int* in_sizes, int n_in, void* d_out, int out_size, void* d_ws, size_t ws_size, hipStream_t stream) {
    (void)in_sizes; (void)n_in; (void)out_size; (void)ws_size;
    static int grid = 0;
    if (grid == 0) {
        int dev = 0, cus = 0, per_cu = 0;
        (void)hipGetDevice(&dev); (void)hipDeviceGetAttribute(&cus, hipDeviceAttributeMultiprocessorCount, dev);
        if (hipFuncSetAttribute((const void*)mk_fwd, hipFuncAttributeMaxDynamicSharedMemorySize, LDS_BYTES) != hipSuccess) { fprintf(stderr, "hipFuncSetAttribute failed\n"); grid = -1; return; }
        (void)hipOccupancyMaxActiveBlocksPerMultiprocessor(&per_cu, (const void*)mk_fwd, NWAVES * 64, LDS_BYTES);
        (void)hipGetLastError();
        if (per_cu < 1) per_cu = 1;
        grid = cus * 1;
        if (grid != 256) fprintf(stderr, "kernel_launch: %d CUs (occupancy query %d/CU)\n", cus, per_cu);
    }
    if (grid < 0) return;
    const float* x = (const float*)d_in[0]; const float* g1 = (const float*)d_in[1]; const float* w_in = (const float*)d_in[2];
    const float* lq1 = (const float*)d_in[3]; const float* lk1 = (const float*)d_in[4]; const float* lq2 = (const float*)d_in[5]; const float* lk2 = (const float*)d_in[6];
    const float* subg = (const float*)d_in[7]; const float* s_lre = (const float*)d_in[8]; const float* s_lim = (const float*)d_in[9]; const float* s_ldt = (const float*)d_in[10];
    const float* s_bre = (const float*)d_in[11]; const float* s_bim = (const float*)d_in[12]; const float* s_cre = (const float*)d_in[13]; const float* s_cim = (const float*)d_in[14];
    const float* s_d = (const float*)d_in[15]; const float* w_glu = (const float*)d_in[16]; const float* w_out = (const float*)d_in[18];
    const float* g2 = (const float*)d_in[19]; const float* w1 = (const float*)d_in[20]; const float* w2 = (const float*)d_in[21];
    unsigned char* ws = (unsigned char*)d_ws;
    bf16_t* WIN = (bf16_t*)(ws + WS_WIN); bf16_t* WGLU = (bf16_t*)(ws + WS_WGLU); bf16_t* WOUT = (bf16_t*)(ws + WS_WOUT); bf16_t* W1T = (bf16_t*)(ws + WS_W1); bf16_t* W2T = (bf16_t*)(ws + WS_W2);
    bf16_t* XN = (bf16_t*)(ws + WS_XN); bf16_t* PROJ = (bf16_t*)(ws + WS_PROJ); bf16_t* MIX = (bf16_t*)(ws + WS_MIX); bf16_t* Z = (bf16_t*)(ws + WS_Z); float* Y = (float*)(ws + WS_Y);
    (void)hipMemsetAsync(ws + WS_CTL, 0, CTL_ZERO_BYTES, stream);
    Args a{};
    for (int i = 0; i < 23; ++i) a.in[i] = (const float*)d_in[i];
    a.out = (float*)d_out; a.ws = ws;

    k_transpose_w<<<dim3(NPROJ / 32, DM / 32), 256, 0, stream>>>(w_in, nullptr, WIN, DM, NPROJ);
    k_transpose_w<<<dim3(SSMW / 32, SSMW / 32), 256, 0, stream>>>(w_glu, nullptr, WGLU, SSMW, SSMW);
    k_transpose_w<<<dim3(DM / 32, DM / 32), 256, 0, stream>>>(w_out, nullptr, WOUT, DM, DM);
    k_transpose_w<<<dim3(FF / 32, DM / 32), 256, 0, stream>>>(w1, g2, W1T, DM, FF);
    k_transpose_w<<<dim3(DM / 32, FF / 32), 256, 0, stream>>>(w2, nullptr, W2T, FF, DM);
    k_rmsnorm_bf16<<<M_TOK / 4, 256, 0, stream>>>(x, g1, XN);
    launch_mk(a, 1, 2, grid, stream);
    k_attn_naive<<<dim3(SEQ / 4, NH, BATCH), 256, 0, stream>>>(PROJ, MIX, lq1, lk1, lq2, lk2, subg);
    k_ssm_naive<<<dim3(NG, BATCH), 64, 0, stream>>>(PROJ, Y, s_lre, s_lim, s_ldt, s_bre, s_bim, s_cre, s_cim);
    k_ssm_post<<<M_TOK * SSMW / 256, 256, 0, stream>>>(Y, PROJ, s_d, Z);
    launch_mk(a, 3, 4, grid, stream);
    launch_mk(a, 4, 5, grid, stream);
    launch_mk(a, 5, 6, grid, stream);
    launch_mk(a, 6, 7, grid, stream);
    launch_mk(a, 7, 8, grid, stream);
}
```

```cpp
#include <hip/hip_runtime.h>
#include <cstdio>
#include <cstdint>
#include <cmath>

typedef unsigned short bf16_t;

constexpr int BATCH = 8, SEQ = 2048, DM = 1024, M_TOK = BATCH * SEQ;
constexpr int NPROJ = 2048, FF = 4096, NH = 4, VD = 128, QKD = 64, SSMW = 512, NG = 32, GC = 16, NP = 64;
constexpr float EPS = 1e-6f;
constexpr float LAMBDA_INIT = 0.2f;

constexpr size_t MiB = 1u << 20;
constexpr size_t WS_WIN = 2 * MiB, WS_WGLU = 6 * MiB, WS_WOUT = 7 * MiB, WS_W1 = 10 * MiB, WS_W2 = 18 * MiB;
constexpr size_t WS_SS1 = 36 * MiB, WS_SS2 = 37 * MiB;
constexpr size_t WS_XN = 40 * MiB, WS_PROJ = 72 * MiB, WS_MIX = 136 * MiB, WS_Z = 168 * MiB, WS_H = 72 * MiB, WS_Y = 200 * MiB;

__device__ __forceinline__ float bf2f(bf16_t v) { return __uint_as_float((unsigned)v << 16); }
__device__ __forceinline__ bf16_t f2bf(float f) { unsigned u = __float_as_uint(f); return (bf16_t)((u + 0x7fffu + ((u >> 16) & 1u)) >> 16); }
__device__ __forceinline__ float wave_sum(float v) {
#pragma unroll
    for (int o = 1; o < 64; o <<= 1) v += __shfl_xor(v, o);
    return v;
}
__device__ __forceinline__ float wave_max(float v) {
#pragma unroll
    for (int o = 1; o < 64; o <<= 1) v = fmaxf(v, __shfl_xor(v, o));
    return v;
}

namespace pg8 {
#define PG8_LAS __attribute__((address_space(3)))
typedef unsigned short bf16_t;
typedef short bf16x8 __attribute__((ext_vector_type(8)));
typedef float f32x4 __attribute__((ext_vector_type(4)));
typedef unsigned u32x4 __attribute__((ext_vector_type(4)));
constexpr int BM = 256, BK = 64, HALF = 128, HTB = HALF * BK * 2  , STAGE_BYTES = 8 * HTB, NXCD = 8, WGM = 8;

__host__ __device__ __forceinline__ int lds_byte(int r, int c) { const int st = (r >> 4) * 2 + (c >> 5), rr = r & 15, cc = c & 31, ob = rr * 64 + cc * 2; return st * 1024 + (ob ^ (((ob >> 9) & 1) << 5)); }
__host__ __device__ __forceinline__ void stage_rc(int b, int& R, int& C) { const int st = b / 1024, sb = b % 1024, swz = sb ^ (((sb >> 9) & 1) << 5); R = (st >> 1) * 16 + swz / 64; C = (st & 1) * 32 + (swz % 64) / 2; }
__host__ __device__ __forceinline__ int perm32(int rho) { const int n = rho >> 4, i = rho & 15; return 8 * (i >> 2) + 4 * n + (i & 3); }

struct Unit { int pm, pn; };
struct Gemm { const bf16_t* A; const bf16_t* Bt; int M, N, K; };

struct StaticOrder {
    int nM, nN, nwg, G, c;
    __host__ __device__ void init(int M, int N, int G_, int c_) { nM = M / BM; nN = N / BM; nwg = nM * nN; G = G_; c = c_; }
    __host__ __device__ bool next(int i, Unit& u) const {
        const long L = (long)i * G + c; if (L >= nwg) return false;
        int wgid = (int)L; { const int q = nwg / NXCD, r = nwg % NXCD, xcd = wgid % NXCD, off = wgid / NXCD; wgid = (xcd < r ? xcd * (q + 1) : r * (q + 1) + (xcd - r) * q) + off; }
        const int nig = WGM * nN, gid = wgid / nig, fm = gid * WGM, gsz = (nM - fm) < WGM ? (nM - fm) : WGM;
        u.pm = fm + ((wgid % nig) % gsz); u.pn = (wgid % nig) / gsz; return true;
    }
    __device__ __forceinline__ void a_ready(const Unit&) const {}
    __device__ __forceinline__ void done(const Unit&) const {}
};

__device__ __forceinline__ unsigned cvt_pk_bf16(float lo, float hi) { unsigned r; asm volatile("v_cvt_pk_bf16_f32 %0, %1, %2" : "=v"(r) : "v"(lo), "v"(hi)); return r; }
typedef float f32x2 __attribute__((ext_vector_type(2)));
__device__ __forceinline__ f32x2 gelu_pk(f32x2 v) {
    const f32x2 av = __builtin_elementwise_abs(v), d = av * 0.2316418882f + 1.0f;
    f32x2 t; t.x = __builtin_amdgcn_rcpf(d.x); t.y = __builtin_amdgcn_rcpf(d.y);
    f32x2 q = t * 0.5307027145f + (-0.7265760135f); q = q * t + 0.7107068705f; q = q * t + (-0.142248368f); q = q * t + 0.127414796f; q = q * t;
    const f32x2 s = (v * v) * (-0.72134752044f);
    f32x2 e; e.x = __builtin_amdgcn_exp2f(s.x); e.y = __builtin_amdgcn_exp2f(s.y);
    const f32x2 m = v * (q * e), r = v - m;
    f32x2 o; o.x = v.x < 0.f ? m.x : r.x; o.y = v.y < 0.f ? m.y : r.y; return o;
}
typedef unsigned u32x2 __attribute__((ext_vector_type(2)));
constexpr float RMS_EPS = 1e-6f;
__device__ __forceinline__ float rstd16(const float* ss, int row) {
    const f32x4* p = (const f32x4*)(ss + (size_t)row * 16); const f32x4 a = p[0], b = p[1], c = p[2], d = p[3];
    const float s = ((a[0] + a[1]) + (a[2] + a[3])) + ((b[0] + b[1]) + (b[2] + b[3])) + ((c[0] + c[1]) + (c[2] + c[3])) + ((d[0] + d[1]) + (d[2] + d[3]));
    return __builtin_amdgcn_rsqf(s * (1.0f / 1024.0f) + RMS_EPS);
}
struct EpiProj {
    static constexpr bool PERM = true, AFTER_DRAIN = false;
    bf16_t* O; int ldc;
    __device__ __forceinline__ void operator()(const f32x4 (&acc)[2][2][4][2], const Unit& u, int wr, int wc, int fr, int fq) const {
        const int row0 = u.pm * BM + wr * 64 + fr, col0 = u.pn * BM + wc * 32 + 8 * fq;
#pragma unroll
        for (int ai = 0; ai < 2; ++ai)
#pragma unroll
            for (int m = 0; m < 4; ++m) { bf16_t* rowp = O + (size_t)(row0 + ai * HALF + m * 16) * ldc + col0;
#pragma unroll
                for (int bj = 0; bj < 2; ++bj) { const f32x4 v0 = acc[ai][bj][m][0], v1 = acc[ai][bj][m][1];
                    u32x4 w; w.x = cvt_pk_bf16(v0[0], v0[1]); w.y = cvt_pk_bf16(v0[2], v0[3]); w.z = cvt_pk_bf16(v1[0], v1[1]); w.w = cvt_pk_bf16(v1[2], v1[3]);
                    *(u32x4*)(rowp + bj * HALF) = w; } }
    }
};
struct EpiGlu {
    static constexpr bool PERM = true, AFTER_DRAIN = false;
    const bf16_t* Z; const float* bias; bf16_t* O;
    __device__ __forceinline__ void operator()(const f32x4 (&acc)[2][2][4][2], const Unit& u, int wr, int wc, int fr, int fq) const {
        const int row0 = u.pm * BM + wr * 64 + fr, col0 = u.pn * BM + wc * 32 + 8 * fq;
        f32x4 bv[2][2];
#pragma unroll
        for (int bj = 0; bj < 2; ++bj)
#pragma unroll
            for (int n = 0; n < 2; ++n) bv[bj][n] = *(const f32x4*)(bias + col0 + bj * HALF + 4 * n);
#pragma unroll
        for (int ai = 0; ai < 2; ++ai)
#pragma unroll
            for (int m = 0; m < 4; ++m) { const size_t row = (size_t)(row0 + ai * HALF + m * 16);
#pragma unroll
                for (int bj = 0; bj < 2; ++bj) { const u32x4 zz = *(const u32x4*)(Z + row * 512 + col0 + bj * HALF);
                    float z[8]; z[0] = __uint_as_float(zz.x << 16); z[1] = __uint_as_float(zz.x & 0xffff0000u); z[2] = __uint_as_float(zz.y << 16); z[3] = __uint_as_float(zz.y & 0xffff0000u);
                    z[4] = __uint_as_float(zz.z << 16); z[5] = __uint_as_float(zz.z & 0xffff0000u); z[6] = __uint_as_float(zz.w << 16); z[7] = __uint_as_float(zz.w & 0xffff0000u);
                    float o[8];
#pragma unroll
                    for (int n = 0; n < 2; ++n)
#pragma unroll
                        for (int i = 0; i < 4; ++i) { const float t = acc[ai][bj][m][n][i] + bv[bj][n][i]; const float s = __builtin_amdgcn_rcpf(1.0f + __builtin_amdgcn_exp2f(-1.4426950408889634f * t)); o[4 * n + i] = z[4 * n + i] * s; }
                    u32x4 w; w.x = cvt_pk_bf16(o[0], o[1]); w.y = cvt_pk_bf16(o[2], o[3]); w.z = cvt_pk_bf16(o[4], o[5]); w.w = cvt_pk_bf16(o[6], o[7]);
                    *(u32x4*)(O + row * 1024 + 512 + col0 + bj * HALF) = w; } }
    }
};
template <bool WRITE_BF> struct EpiResid {
    static constexpr bool PERM = false, AFTER_DRAIN = false;
    const float* base; float* out; bf16_t* hb; float* ss;
    __device__ __forceinline__ void operator()(const f32x4 (&acc)[2][2][4][2], const Unit& u, int wr, int wc, int fr, int fq) const {
        const int row0 = u.pm * BM + wr * 64 + fr, col0 = u.pn * BM + wc * 32 + 4 * fq;
#pragma unroll
        for (int ai = 0; ai < 2; ++ai)
#pragma unroll
            for (int m = 0; m < 4; ++m) { const int row = row0 + ai * HALF + m * 16; const size_t off = (size_t)row * 1024 + col0; float s = 0.f;
#pragma unroll
                for (int bj = 0; bj < 2; ++bj)
#pragma unroll
                    for (int n = 0; n < 2; ++n) { const f32x4 h = *(const f32x4*)(base + off + bj * HALF + n * 16) + acc[ai][bj][m][n];
                        *(f32x4*)(out + off + bj * HALF + n * 16) = h; s += (h[0] * h[0] + h[1] * h[1]) + (h[2] * h[2] + h[3] * h[3]);
                        if (WRITE_BF) { u32x2 w; w.x = cvt_pk_bf16(h[0], h[1]); w.y = cvt_pk_bf16(h[2], h[3]); *(u32x2*)(hb + off + bj * HALF + n * 16) = w; } }
                s += __shfl_xor(s, 16); s += __shfl_xor(s, 32);
                if (fq == 0) ss[(size_t)row * 16 + u.pn * 4 + wc] = s; }
    }
};
struct EpiUp {
    static constexpr bool PERM = true, AFTER_DRAIN = false;
    bf16_t* O; int ldc; const float* ss;
    __device__ __forceinline__ void operator()(const f32x4 (&acc)[2][2][4][2], const Unit& u, int wr, int wc, int fr, int fq) const {
        const int row0 = u.pm * BM + wr * 64 + fr, col0 = u.pn * BM + wc * 32 + 8 * fq;
#pragma unroll
        for (int ai = 0; ai < 2; ++ai)
#pragma unroll
            for (int m = 0; m < 4; ++m) { const int row = row0 + ai * HALF + m * 16; const float r = rstd16(ss, row); bf16_t* rowp = O + (size_t)row * ldc + col0;
#pragma unroll
                for (int bj = 0; bj < 2; ++bj) { f32x4 v0 = acc[ai][bj][m][0] * r, v1 = acc[ai][bj][m][1] * r;
#pragma unroll
                    for (int i = 0; i < 4; ++i) { const float a = fmaxf(v0[i], 0.f), b = fmaxf(v1[i], 0.f); v0[i] = a * a; v1[i] = b * b; }
                    u32x4 w; w.x = cvt_pk_bf16(v0[0], v0[1]); w.y = cvt_pk_bf16(v0[2], v0[3]); w.z = cvt_pk_bf16(v1[0], v1[1]); w.w = cvt_pk_bf16(v1[2], v1[3]);
                    *(u32x4*)(rowp + bj * HALF) = w; } }
    }
};
template <class Epi, class Sched, bool ALIGN_EPI = false, bool SP2 = false>
__device__ __forceinline__ void gemm_phase(PG8_LAS unsigned char* lds, const Gemm g, const Sched& S, const Epi& E) {
    const int tid = threadIdx.x, wid = __builtin_amdgcn_readfirstlane(tid >> 6), lane = tid & 63, wr = wid >> 2, wc = wid & 3, fr = lane & 15, fq = lane >> 4;
    const int K = g.K, nt = K / BK;
    unsigned voffA[2], voffB[2];
#pragma unroll
    for (int i = 0; i < 2; ++i) { int R, C; stage_rc(tid * 16 + i * 8192, R, C); const int Rb = Epi::PERM ? ((R & ~31) + perm32(R & 31)) : R;
        voffA[i] = (unsigned)(R * K + C) * 2u; voffB[i] = (unsigned)(Rb * K + C) * 2u; }
    const size_t kstep = (size_t)(BK * 2);
    const size_t hstep = (size_t)HALF * K * 2;
    const size_t tstep = 2 * hstep;
    const unsigned ldsw = (unsigned)wid * 1024u;
    const int aoff = lds_byte(wr * 64 + fr, fq * 8), boff = lds_byte(wc * 32 + fr, fq * 8);
#define PG8_SA(b, h) (((b) * 2 + (h)) * HTB)
#define PG8_SB(b, h) ((4 + (b) * 2 + (h)) * HTB)
#define PG8_STAGE(bufoff, gbase, voff) do { _Pragma("unroll") for (int _i = 0; _i < 2; ++_i) \
        __builtin_amdgcn_global_load_lds((const unsigned*)((const char*)(gbase) + (voff)[_i]), (PG8_LAS unsigned*)(lds + (bufoff) + ldsw + _i * 8192), 16, 0, 0); } while (0)
#define PG8_LDA(dst, b, h) do { _Pragma("unroll") for (int m = 0; m < 4; ++m) _Pragma("unroll") for (int k = 0; k < 2; ++k) dst[m][k] = *(const PG8_LAS bf16x8*)(lds + PG8_SA(b, h) + aoff + m * 2048 + k * 1024); } while (0)
#define PG8_LDB(dst, b, h) do { _Pragma("unroll") for (int n = 0; n < 2; ++n) _Pragma("unroll") for (int k = 0; k < 2; ++k) dst[n][k] = *(const PG8_LAS bf16x8*)(lds + PG8_SB(b, h) + boff + n * 2048 + k * 1024); } while (0)
#define PG8_MMA(ai, bj, At, Bt) do { __builtin_amdgcn_s_setprio(1); _Pragma("unroll") for (int m = 0; m < 4; ++m) _Pragma("unroll") for (int n = 0; n < 2; ++n) _Pragma("unroll") for (int k = 0; k < 2; ++k) \
        acc[ai][bj][m][n] = __builtin_amdgcn_mfma_f32_16x16x32_bf16(Bt[n][k], At[m][k], acc[ai][bj][m][n], 0, 0, 0); __builtin_amdgcn_s_setprio(0); } while (0)
#define PG8_WAIT_V(n) asm volatile("s_waitcnt vmcnt(" #n ")" ::: "memory")
#define PG8_WAIT_L(n) asm volatile("s_waitcnt lgkmcnt(" #n ")" ::: "memory")
#define PG8_BAR __builtin_amdgcn_s_barrier()
#define PG8_SCHED __builtin_amdgcn_sched_barrier(0)
    Unit cur, nxt; int ui = 0;
    if (!S.next(0, cur)) return;
    f32x4 acc[2][2][4][2];
#pragma unroll
    for (int a = 0; a < 2; ++a)
#pragma unroll
        for (int b = 0; b < 2; ++b)
#pragma unroll
            for (int m = 0; m < 4; ++m)
#pragma unroll
                for (int n = 0; n < 2; ++n) acc[a][b][m][n] = (f32x4){0.f, 0.f, 0.f, 0.f};
    bf16x8 At[4][2], B0[2][2], B1[2][2];
    const char* cA = (const char*)g.A + (size_t)cur.pm * tstep; const char* cB = (const char*)g.Bt + (size_t)cur.pn * tstep;
    S.a_ready(cur);
    if constexpr (SP2) {
        PG8_STAGE(PG8_SB(0, 0), cB, voffB); PG8_STAGE(PG8_SB(0, 1), cB + hstep, voffB); PG8_STAGE(PG8_SA(0, 0), cA, voffA); PG8_STAGE(PG8_SA(0, 1), cA + hstep, voffA);
        if (wr == 1) PG8_BAR;
        PG8_WAIT_V(2); PG8_BAR;
        PG8_STAGE(PG8_SB(1, 0), cB + kstep, voffB); PG8_STAGE(PG8_SA(1, 0), cA + kstep, voffA); PG8_STAGE(PG8_SB(1, 1), cB + hstep + kstep, voffB);
        PG8_WAIT_V(6); PG8_BAR;
    } else {
        PG8_STAGE(PG8_SB(0, 0), cB, voffB); PG8_STAGE(PG8_SA(0, 0), cA, voffA); PG8_STAGE(PG8_SB(0, 1), cB + hstep, voffB); PG8_STAGE(PG8_SA(0, 1), cA + hstep, voffA);
        if (wr == 1) PG8_BAR;
        PG8_WAIT_V(4); PG8_BAR;
        PG8_STAGE(PG8_SB(1, 0), cB + kstep, voffB); PG8_STAGE(PG8_SA(1, 0), cA + kstep, voffA); PG8_STAGE(PG8_SB(1, 1), cB + hstep + kstep, voffB);
        PG8_WAIT_V(6); PG8_BAR;
    }
    for (;;) {
        const bool has_next = S.next(ui + 1, nxt);
        const char* nA = has_next ? (const char*)g.A + (size_t)nxt.pm * tstep : cA; const char* nB = has_next ? (const char*)g.Bt + (size_t)nxt.pn * tstep : cB;
        for (int t = 0; t < nt; t += 2) {
            const bool last = (t == nt - 2);
            const char* a1 = cA + (size_t)(t + 1) * kstep;
            const char* a2 = last ? nA : cA + (size_t)(t + 2) * kstep; const char* b2 = last ? nB : cB + (size_t)(t + 2) * kstep;
            const char* a3 = a2 + kstep; const char* b3 = b2 + kstep;
            if (last && has_next) S.a_ready(nxt);
            if constexpr (SP2) {
            PG8_LDB(B0, 0, 0); PG8_LDB(B1, 0, 1); PG8_SCHED; PG8_LDA(At, 0, 0); PG8_STAGE(PG8_SA(1, 1), a1 + hstep, voffA);
            PG8_WAIT_V(8); PG8_WAIT_L(0); PG8_BAR; PG8_MMA(0, 0, At, B0); PG8_MMA(0, 1, At, B1); PG8_BAR; PG8_SCHED;
            PG8_LDA(At, 0, 1); PG8_STAGE(PG8_SB(0, 0), b2, voffB); PG8_STAGE(PG8_SB(0, 1), b2 + hstep, voffB); PG8_STAGE(PG8_SA(0, 0), a2, voffA);
            PG8_WAIT_V(8); PG8_WAIT_L(0); PG8_BAR; PG8_MMA(1, 0, At, B0); PG8_MMA(1, 1, At, B1); PG8_BAR; PG8_SCHED;
            PG8_LDB(B0, 1, 0); PG8_LDB(B1, 1, 1); PG8_SCHED; PG8_LDA(At, 1, 0); PG8_STAGE(PG8_SA(0, 1), a2 + hstep, voffA);
            PG8_WAIT_V(8); PG8_WAIT_L(0); PG8_BAR; PG8_MMA(0, 0, At, B0); PG8_MMA(0, 1, At, B1); PG8_BAR; PG8_SCHED;
            PG8_LDA(At, 1, 1); PG8_STAGE(PG8_SB(1, 0), b3, voffB); PG8_STAGE(PG8_SB(1, 1), b3 + hstep, voffB); PG8_STAGE(PG8_SA(1, 0), a3, voffA);
            PG8_WAIT_V(8); PG8_WAIT_L(0); PG8_BAR; PG8_MMA(1, 0, At, B0); PG8_MMA(1, 1, At, B1); PG8_BAR; PG8_SCHED;
            } else {
            PG8_LDB(B0, 0, 0); PG8_SCHED; PG8_LDA(At, 0, 0); PG8_STAGE(PG8_SA(1, 1), a1 + hstep, voffA);
            PG8_WAIT_L(8); PG8_BAR; PG8_WAIT_L(0); PG8_MMA(0, 0, At, B0); PG8_BAR; PG8_SCHED;
            PG8_LDB(B1, 0, 1); PG8_STAGE(PG8_SB(0, 0), b2, voffB);
            PG8_BAR; PG8_WAIT_L(0); PG8_MMA(0, 1, At, B1); PG8_BAR;
            PG8_LDA(At, 0, 1); PG8_STAGE(PG8_SA(0, 0), a2, voffA);
            PG8_BAR; PG8_WAIT_L(0); PG8_MMA(1, 0, At, B0); PG8_BAR; PG8_SCHED;
            PG8_STAGE(PG8_SB(0, 1), b2 + hstep, voffB);
            PG8_WAIT_V(6); PG8_BAR; PG8_MMA(1, 1, At, B1); PG8_BAR;
            PG8_LDB(B0, 1, 0); PG8_SCHED; PG8_LDA(At, 1, 0); PG8_STAGE(PG8_SA(0, 1), a2 + hstep, voffA);
            PG8_WAIT_L(8); PG8_BAR; PG8_WAIT_L(0); PG8_MMA(0, 0, At, B0); PG8_BAR; PG8_SCHED;
            PG8_LDB(B1, 1, 1); PG8_STAGE(PG8_SB(1, 0), b3, voffB);
            PG8_BAR; PG8_WAIT_L(0); PG8_MMA(0, 1, At, B1); PG8_BAR;
            PG8_LDA(At, 1, 1); PG8_STAGE(PG8_SA(1, 0), a3, voffA);
            PG8_BAR; PG8_WAIT_L(0); PG8_MMA(1, 0, At, B0); PG8_BAR; PG8_SCHED;
            PG8_STAGE(PG8_SB(1, 1), b3 + hstep, voffB);
            PG8_WAIT_V(6); PG8_BAR; PG8_MMA(1, 1, At, B1); PG8_BAR;
            }
        }
        if constexpr (ALIGN_EPI) { if (wr == 0) PG8_BAR; }
        if constexpr (!Epi::AFTER_DRAIN) { E(acc, cur, wr, wc, fr, fq); S.done(cur); }
        if (!has_next) break;
#pragma unroll
        for (int a = 0; a < 2; ++a)
#pragma unroll
            for (int b = 0; b < 2; ++b)
#pragma unroll
                for (int m = 0; m < 4; ++m)
#pragma unroll
                    for (int n = 0; n < 2; ++n) acc[a][b][m][n] = (f32x4){0.f, 0.f, 0.f, 0.f};
        cur = nxt; cA = nA; cB = nB; ++ui;
        if constexpr (ALIGN_EPI) { if (wr == 1) PG8_BAR; }
    }
    PG8_WAIT_V(0);
    if constexpr (!ALIGN_EPI) { if (wr == 0) PG8_BAR; }
    PG8_BAR;
    if constexpr (Epi::AFTER_DRAIN) { E.fused(acc, cur, wr, wc, fr, fq, lds, wid, lane); S.done(cur); }
#undef PG8_SA
#undef PG8_SB
#undef PG8_STAGE
#undef PG8_LDA
#undef PG8_LDB
#undef PG8_MMA
#undef PG8_WAIT_V
#undef PG8_WAIT_L
#undef PG8_BAR
#undef PG8_SCHED
}
}
namespace attn {
using bf16x8 = __attribute__((ext_vector_type(8))) short;
using s16x4  = __attribute__((ext_vector_type(4))) short;
using f32x16 = __attribute__((ext_vector_type(16))) float;
using f32x4v = __attribute__((ext_vector_type(4))) float;
using u32x4  = __attribute__((ext_vector_type(4))) unsigned;
constexpr int LDP = 2048;
constexpr int KVBLK = 64, NT = SEQ / KVBLK;
constexpr int SHM_V = KVBLK * 128 * 2, SHM_K = KVBLK * 128 * 2;
constexpr int OFF_V = 0, OFF_K = 2 * SHM_V, OFF_WS = OFF_K + 2 * SHM_K, OFF_X = OFF_WS + 8 * 64 * 4, XROW = 132, X_BYTES = 4 * 32 * XROW * 4, ATTN_LDS = OFF_X + X_BYTES;
constexpr float C2 = 0.125f * 1.4426950408889634f;
constexpr float THR2 = 8.0f;
#define KSWZ(row, colB) ((row) * 256 + ((colB) ^ (((row) & 7) << 4)))
#define SBAR() __builtin_amdgcn_sched_barrier(0)
__device__ __forceinline__ int crow(int r, int hi) { return (r & 3) + 8 * (r >> 2) + 4 * hi; }
__device__ __forceinline__ unsigned cvtpk(float lo, float hi) { unsigned r; asm volatile("v_cvt_pk_bf16_f32 %0, %1, %2" : "=v"(r) : "v"(lo), "v"(hi)); return r; }
__device__ __forceinline__ int v_st(int k, int c) { const int kk = (k & ~0xC) | ((k & 4) << 1) | ((k & 8) >> 1); return ((kk >> 3) * 4 + (c >> 5)) * 512 + ((kk & 7) * 32 + (c & 31)) * 2; }
__device__ __forceinline__ int v_rd_base(int lane) { return ((lane & 3) << 3) | (((lane >> 2) & 3) << 6) | (((lane >> 4) & 1) << 5) | (((lane >> 5) & 1) << 8); }
constexpr int v_rd_off(int d0, int ks, int half) { return d0 * 512 + ks * 4096 + half * 2048; }
template <int OFF> __device__ __forceinline__ s16x4 tr_read(int vb) { s16x4 r; asm volatile("ds_read_b64_tr_b16 %0, %1 offset:%2" : "=&v"(r) : "v"(vb), "i"(OFF) : "memory"); return r; }
template <int D0> __device__ __forceinline__ void pv_one(f32x16& od, int vb, bf16x8 pa0, bf16x8 pa1, bf16x8 pa2, bf16x8 pa3) {
  const s16x4 l0 = tr_read<v_rd_off(D0, 0, 0)>(vb), h0 = tr_read<v_rd_off(D0, 0, 1)>(vb), l1 = tr_read<v_rd_off(D0, 1, 0)>(vb), h1 = tr_read<v_rd_off(D0, 1, 1)>(vb);
  const s16x4 l2 = tr_read<v_rd_off(D0, 2, 0)>(vb), h2 = tr_read<v_rd_off(D0, 2, 1)>(vb), l3 = tr_read<v_rd_off(D0, 3, 0)>(vb), h3 = tr_read<v_rd_off(D0, 3, 1)>(vb);
  asm volatile("s_waitcnt lgkmcnt(0)" ::: "memory"); SBAR();
#define PK(L, H) (bf16x8){L[0], L[1], L[2], L[3], H[0], H[1], H[2], H[3]}
  od = __builtin_amdgcn_mfma_f32_32x32x16_bf16(pa0, PK(l0, h0), od, 0, 0, 0);
  od = __builtin_amdgcn_mfma_f32_32x32x16_bf16(pa1, PK(l1, h1), od, 0, 0, 0);
  od = __builtin_amdgcn_mfma_f32_32x32x16_bf16(pa2, PK(l2, h2), od, 0, 0, 0);
  od = __builtin_amdgcn_mfma_f32_32x32x16_bf16(pa3, PK(l3, h3), od, 0, 0, 0);
#undef PK
}
__device__ __forceinline__ void pv_d0(f32x16* o, int vb, bf16x8 pa0, bf16x8 pa1, bf16x8 pa2, bf16x8 pa3) {
  pv_one<0>(o[0], vb, pa0, pa1, pa2, pa3); pv_one<1>(o[1], vb, pa0, pa1, pa2, pa3); pv_one<2>(o[2], vb, pa0, pa1, pa2, pa3); pv_one<3>(o[3], vb, pa0, pa1, pa2, pa3);
}
__device__ __forceinline__ void qkt(f32x16& p0, f32x16& p1, const char* Ks, const bf16x8* qr, int c, int r32, int hi) {
  p0 = f32x16{}; p1 = f32x16{};
#pragma unroll
  for (int d0 = 0; d0 < 4; ++d0) { const int cb = ((4 * c + d0) * 16 + hi * 8) * 2;
    const bf16x8 b0 = *reinterpret_cast<const bf16x8*>(Ks + KSWZ(r32, cb));
    const bf16x8 b1 = *reinterpret_cast<const bf16x8*>(Ks + KSWZ(32 + r32, cb));
    p0 = __builtin_amdgcn_mfma_f32_32x32x16_bf16(b0, qr[d0], p0, 0, 0, 0);
    p1 = __builtin_amdgcn_mfma_f32_32x32x16_bf16(b1, qr[d0], p1, 0, 0, 0); }
}
__device__ __forceinline__ void partialSM(f32x16& p0, f32x16& p1, float dq, float jb, float nsl2, float& m_reg, float& alpha) {
  const float db = dq - jb;
#pragma unroll
  for (int r = 0; r < 16; ++r) { const float d = db - (float)((r & 3) + 8 * (r >> 2)); p0[r] = fmaf(p0[r], C2, nsl2 * fabsf(d)); p1[r] = fmaf(p1[r], C2, nsl2 * fabsf(d - 32.f)); }
  float pmax = p0[0];
#pragma unroll
  for (int r = 1; r < 16; ++r) pmax = fmaxf(pmax, p0[r]);
#pragma unroll
  for (int r = 0; r < 16; ++r) pmax = fmaxf(pmax, p1[r]);
  { auto rr = __builtin_amdgcn_permlane32_swap(__float_as_uint(pmax), __float_as_uint(pmax), false, false); pmax = fmaxf(__uint_as_float(rr[0]), __uint_as_float(rr[1])); }
  float mn;
  if (__builtin_expect(__all(pmax - m_reg <= THR2), 1)) { mn = m_reg; alpha = 1.f; }
  else { mn = fmaxf(m_reg, pmax); alpha = __builtin_amdgcn_exp2f(m_reg - mn); m_reg = mn; }
#pragma unroll
  for (int r = 0; r < 16; ++r) { p0[r] = __builtin_amdgcn_exp2f(p0[r] - mn); p1[r] = p1[r] - mn; }
}
__device__ __forceinline__ void finishSM(f32x16& p0, f32x16& p1, float alpha, float& l_reg, bf16x8& pa0, bf16x8& pa1, bf16x8& pa2, bf16x8& pa3) {
#pragma unroll
  for (int r = 0; r < 16; ++r) p1[r] = __builtin_amdgcn_exp2f(p1[r]);
  float ps = 0;
#pragma unroll
  for (int r = 0; r < 16; ++r) ps += p0[r];
#pragma unroll
  for (int r = 0; r < 16; ++r) ps += p1[r];
  { auto rr = __builtin_amdgcn_permlane32_swap(__float_as_uint(ps), __float_as_uint(ps), false, false); ps = __uint_as_float(rr[0]) + __uint_as_float(rr[1]); }
  l_reg = l_reg * alpha + ps;
#define PK4(P, BASE, OUT) do { unsigned a0 = cvtpk(P[BASE + 0], P[BASE + 1]), a1 = cvtpk(P[BASE + 2], P[BASE + 3]);   \
    unsigned b0 = cvtpk(P[BASE + 4], P[BASE + 5]), b1 = cvtpk(P[BASE + 6], P[BASE + 7]);                              \
    auto r0 = __builtin_amdgcn_permlane32_swap(a0, b0, false, false); auto r1 = __builtin_amdgcn_permlane32_swap(a1, b1, false, false); \
    u32x4 w = {r0[0], r1[0], r0[1], r1[1]}; OUT = *reinterpret_cast<bf16x8*>(&w); } while (0)
  PK4(p0, 0, pa0); PK4(p0, 8, pa1); PK4(p1, 0, pa2); PK4(p1, 8, pa3);
#undef PK4
}
__device__ __forceinline__ int tile_at(int k, int tc) {
  if (k == 0) return tc;
  const int nL = tc, nR = NT - 1 - tc, m = nL < nR ? nL : nR;
  if (k <= 2 * m) return (k & 1) ? tc + ((k + 1) >> 1) : tc - (k >> 1);
  const int rest = k - 2 * m; return nR > nL ? tc + m + rest : tc - m - rest;
}
__device__ __forceinline__ void attn_unit(int b, int h, int qb, const bf16_t* __restrict__ proj, bf16_t* __restrict__ mix, float lam, const float* __restrict__ subg, char* lds) {
  const int tid = threadIdx.x, wid = tid >> 6, lane = tid & 63, r32 = lane & 31, hi = lane >> 5;
  const int c = wid & 1, qblk = wid >> 1;
  char* V_lds = lds + OFF_V; char* K_lds = lds + OFF_K;
  float* wsf = (float*)(lds + OFF_WS) + wid * 64; float* li_l = wsf; float* al_l = wsf + 32;
  const long rowbase = (long)b * SEQ; const int q0 = qb * 128 + qblk * 32;
  const bf16_t* Kh = proj + rowbase * LDP + 512 + h * 128; const bf16_t* Vh = proj + rowbase * LDP + 1024 + h * 128;
  float m_reg = -1e30f, l_reg = 0.f; f32x16 o[4] = {}; bf16x8 qr[4];
  { const bf16_t* Qw = proj + (rowbase + q0 + r32) * LDP + h * 128 + c * 64 + hi * 8;
#pragma unroll
    for (int d0 = 0; d0 < 4; ++d0) qr[d0] = *reinterpret_cast<const bf16x8*>(Qw + d0 * 16); }
  const float nsl2 = -exp2f(-2.0f * (float)(h + 1)) * 1.4426950408889634f;
  const float dl = (float)(q0 + r32 - 4 * hi);
  const int sr = tid >> 4, sc = (tid & 15) * 8, vst0 = v_st(sr, sc), vst1 = v_st(32 + sr, sc);
  const int vb0 = (int)(uintptr_t)V_lds + v_rd_base(lane);
  const int tc = (qb * 128) / KVBLK;
  struct { bf16x8 vs0, vs1, ks0, ks1; } sr_[2];
#define SLOAD(i, t) do { const long k0_ = (long)(t) * KVBLK; sr_[i].vs0 = *reinterpret_cast<const bf16x8*>(&Vh[(k0_ + sr) * LDP + sc]); sr_[i].vs1 = *reinterpret_cast<const bf16x8*>(&Vh[(k0_ + 32 + sr) * LDP + sc]); \
    sr_[i].ks0 = *reinterpret_cast<const bf16x8*>(&Kh[(k0_ + sr) * LDP + sc]); sr_[i].ks1 = *reinterpret_cast<const bf16x8*>(&Kh[(k0_ + 32 + sr) * LDP + sc]); } while (0)
#define SWRITE(bf, i) do { *(bf16x8*)(V_lds + (bf) * SHM_V + vst0) = sr_[i].vs0; *(bf16x8*)(V_lds + (bf) * SHM_V + vst1) = sr_[i].vs1; const int kc = sc * 2;   \
    *(bf16x8*)(K_lds + (bf) * SHM_K + KSWZ(sr, kc)) = sr_[i].ks0; *(bf16x8*)(K_lds + (bf) * SHM_K + KSWZ(32 + sr, kc)) = sr_[i].ks1; } while (0)
#define SWAIT() asm volatile("s_waitcnt vmcnt(4)" ::: "memory")
#define RESC(a) do { if (__any((a) < 1.f)) { if (hi == 0) al_l[r32] = (a); asm volatile("s_waitcnt lgkmcnt(0)" ::: "memory"); \
    _Pragma("unroll") for (int d = 0; d < 4; ++d) _Pragma("unroll") for (int r = 0; r < 16; ++r) o[d][r] *= al_l[crow(r, hi)]; } } while (0)
#define JB(k) ((float)(tile_at((k), tc) * KVBLK))
  f32x16 pA0, pA1, pB0, pB1; float alA, alB; bf16x8 pa0, pa1, pa2, pa3;
  constexpr int SE = 0, SO = 1;
  SLOAD(SE, tile_at(0, tc)); asm volatile("s_waitcnt vmcnt(0)" ::: "memory"); SWRITE(0, SE); __syncthreads();
  qkt(pA0, pA1, K_lds, qr, c, r32, hi); partialSM(pA0, pA1, dl, JB(0), nsl2, m_reg, alA);
  SLOAD(SO, tile_at(1, tc)); SLOAD(SE, tile_at(2, tc));
  SWAIT(); SWRITE(1, SO); __syncthreads();
  for (int j = 1; j + 1 < NT; j += 2) {
    SBAR(); qkt(pB0, pB1, K_lds + SHM_K, qr, c, r32, hi);
    finishSM(pA0, pA1, alA, l_reg, pa0, pa1, pa2, pa3); SBAR();
    SLOAD(SO, tile_at(j + 2, tc)); SBAR();
    pv_d0(o, vb0, pa0, pa1, pa2, pa3); partialSM(pB0, pB1, dl, JB(j), nsl2, m_reg, alB);
    __syncthreads(); SWAIT(); SWRITE(0, SE);
    RESC(alB); __syncthreads();
    SBAR(); qkt(pA0, pA1, K_lds, qr, c, r32, hi);
    finishSM(pB0, pB1, alB, l_reg, pa0, pa1, pa2, pa3); SBAR();
    if (j + 3 < NT) SLOAD(SE, tile_at(j + 3, tc)); SBAR();
    pv_d0(o, vb0 + SHM_V, pa0, pa1, pa2, pa3); partialSM(pA0, pA1, dl, JB(j + 1), nsl2, m_reg, alA);
    __syncthreads(); SWAIT(); SWRITE(1, SO);
    RESC(alA); __syncthreads();
  }
  SBAR(); qkt(pB0, pB1, K_lds + SHM_K, qr, c, r32, hi);
  finishSM(pA0, pA1, alA, l_reg, pa0, pa1, pa2, pa3); SBAR();
  pv_d0(o, vb0, pa0, pa1, pa2, pa3); partialSM(pB0, pB1, dl, JB(NT - 1), nsl2, m_reg, alB);
  __syncthreads(); RESC(alB);
  finishSM(pB0, pB1, alB, l_reg, pa0, pa1, pa2, pa3); SBAR();
  pv_d0(o, vb0 + SHM_V, pa0, pa1, pa2, pa3);
  if (hi == 0) li_l[r32] = l_reg; asm volatile("s_waitcnt lgkmcnt(0)" ::: "memory");
  float rli[16]; const float scl = c ? lam : 1.f;
#pragma unroll
  for (int r = 0; r < 16; ++r) rli[r] = __builtin_amdgcn_rcpf(li_l[crow(r, hi)]) * scl;
  float* X = (float*)(lds + OFF_X) + qblk * (32 * XROW);
  if (c == 1) {
#pragma unroll
    for (int r = 0; r < 16; ++r)
#pragma unroll
      for (int d0 = 0; d0 < 4; ++d0) X[crow(r, hi) * XROW + d0 * 32 + r32] = o[d0][r] * rli[r];
  }
  __syncthreads();
  if (c == 0) {
#pragma unroll
    for (int r = 0; r < 16; ++r)
#pragma unroll
      for (int d0 = 0; d0 < 4; ++d0) { float* xp = &X[crow(r, hi) * XROW + d0 * 32 + r32]; *xp = o[d0][r] * rli[r] - *xp; }
    asm volatile("s_waitcnt lgkmcnt(0)" ::: "memory");
    f32x4v v[16]; float ss = 0.f;
    const float* xr = X + r32 * XROW + hi * 64;
#pragma unroll
    for (int k = 0; k < 16; ++k) { v[k] = *(const f32x4v*)(xr + 4 * k); ss += (v[k][0] * v[k][0] + v[k][1] * v[k][1]) + (v[k][2] * v[k][2] + v[k][3] * v[k][3]); }
    { auto rr = __builtin_amdgcn_permlane32_swap(__float_as_uint(ss), __float_as_uint(ss), false, false); ss = __uint_as_float(rr[0]) + __uint_as_float(rr[1]); }
    const float rs = __builtin_amdgcn_rsqf(ss * (1.0f / 128.0f) + 1e-6f) * (1.0f - LAMBDA_INIT);
    bf16_t* orow = mix + (rowbase + q0 + r32) * 1024 + h * 128 + hi * 64; const float* gp = subg + hi * 64;
#pragma unroll
    for (int k = 0; k < 8; ++k) { const f32x4v a = v[2 * k] * rs * *(const f32x4v*)(gp + 8 * k), bq = v[2 * k + 1] * rs * *(const f32x4v*)(gp + 8 * k + 4);
      u32x4 w; w.x = cvtpk(a[0], a[1]); w.y = cvtpk(a[2], a[3]); w.z = cvtpk(bq[0], bq[1]); w.w = cvtpk(bq[2], bq[3]); *(u32x4*)(orow + 8 * k) = w; }
  }
  __syncthreads();
#undef SLOAD
#undef SWRITE
#undef SWAIT
#undef RESC
#undef JB
}
#undef KSWZ
#undef SBAR
}
#define GAS __attribute__((address_space(1)))
#define LAS __attribute__((address_space(3)))
typedef unsigned v4u __attribute__((ext_vector_type(4)));
typedef float f32x4 __attribute__((ext_vector_type(4)));
typedef GAS unsigned gu32;
#define RLX_AGENT __ATOMIC_RELAXED, __HIP_MEMORY_SCOPE_AGENT
#define LDS_WAIT() asm volatile("s_waitcnt lgkmcnt(0)" ::: "memory")
#define VM_WAIT() asm volatile("s_waitcnt vmcnt(0)" ::: "memory")
constexpr int NWAVES = 8;
constexpr int RING_OFF = 0, RING_BYTES = 139264, LDSCTL_OFF = RING_BYTES, MISC_OFF = LDSCTL_OFF + 320, LDS_BYTES = 147456;
constexpr size_t WS_CTL = 0, CTL_ZERO_BYTES = 1 * MiB;
constexpr int CW_BAR = 4096;
#define XB_TMO      128
#define XB_XCNT(j)  (256  + 64 * (j))
#define XB_XSUB(j)  (1280 + 64 * (j))
#define XB_XGEN(j)  (2304 + 64 * (j))
#define XB_TOP      3328
#define XB_TOPGEN   3392
#define XCD_BAR_WORDS 3456
#define XB_SPIN_CAP (1u << 18)

__device__ __forceinline__ unsigned xb_ld(unsigned* p)              { return __hip_atomic_load(p, __ATOMIC_RELAXED, __HIP_MEMORY_SCOPE_AGENT); }
__device__ __forceinline__ unsigned xb_add(unsigned* p, unsigned v) { return __hip_atomic_fetch_add(p, v, __ATOMIC_RELAXED, __HIP_MEMORY_SCOPE_AGENT); }
__device__ __forceinline__ unsigned xb_xcc_id() { return (unsigned)__builtin_amdgcn_s_getreg((3 << 11) | 20) & 0xFu; }
#define XB_SPIN(cond, bar) do { unsigned _sp = 0; while (cond) { __builtin_amdgcn_s_sleep(1); \
    if ((++_sp & 255u) == 0u) { if (xb_ld(&(bar)[XB_TMO])) break; if (_sp > XB_SPIN_CAP) { atomicAdd(&(bar)[XB_TMO], 1u); break; } } } } while (0)

struct XcdBarrier {
    unsigned* bar; unsigned x;
    volatile LAS unsigned* st;
};

__device__ __forceinline__ XcdBarrier xcd_barrier_post(unsigned* bar, volatile LAS unsigned* st) {
    XcdBarrier b; b.bar = bar; b.x = xb_xcc_id(); b.st = st;
    if (threadIdx.x == 0) (void)xb_add(&bar[XB_XCNT(b.x)], 1u);
    return b;
}
__device__ __forceinline__ void xcd_barrier_complete(unsigned* bar, unsigned x, unsigned& nloc, unsigned& nx) {
    const unsigned G = gridDim.x * gridDim.y * gridDim.z;
    unsigned sum, cnt, mine, sp = 0u;
    for (;;) {
        sum = 0u; cnt = 0u; mine = 0u;
#pragma unroll
        for (unsigned j = 0; j < 16; ++j) { const unsigned c = xb_ld(&bar[XB_XCNT(j)]); sum += c; cnt += (c > 0u) ? 1u : 0u; mine = (j == x) ? c : mine; }
        if (sum == G) break;
        __builtin_amdgcn_s_sleep(1);
        if ((++sp & 255u) == 0u) { if (xb_ld(&bar[XB_TMO])) break; if (sp > XB_SPIN_CAP) { atomicAdd(&bar[XB_TMO], 1u); break; } }
    }
    nloc = mine > 0u ? mine : 1u; nx = cnt > 0u ? cnt : 1u;
}

__device__ __forceinline__ void xcd_barrier(const XcdBarrier& b) {
    asm volatile("s_waitcnt vmcnt(0)" ::: "memory");
    __syncthreads();
    if (threadIdx.x == 0) {
        unsigned* bar = b.bar;
        __builtin_amdgcn_s_waitcnt(0);
        unsigned nloc = b.st[0], nx = b.st[1];
        if (nloc == 0u) { xcd_barrier_complete(bar, b.x, nloc, nx); b.st[0] = nloc; b.st[1] = nx; }
        const unsigned old = xb_add(&bar[XB_XSUB(b.x)], 1u);
        const unsigned gen = old / nloc;
        if (old + 1u == (gen + 1u) * nloc) {
            __builtin_amdgcn_fence(__ATOMIC_RELEASE, "agent");
            asm volatile("s_waitcnt vmcnt(0)" ::: "memory");
            const unsigned og = xb_add(&bar[XB_TOP], 1u);
            const unsigned tg = og / nx;
            if (og + 1u == (tg + 1u) * nx) xb_add(&bar[XB_TOPGEN], 1u);
            else XB_SPIN(xb_ld(&bar[XB_TOPGEN]) == tg, bar);
            __builtin_amdgcn_fence(__ATOMIC_ACQUIRE, "agent");
            xb_add(&bar[XB_XGEN(b.x)], 1u);
            asm volatile("s_waitcnt vmcnt(0)" ::: "memory");
        } else {
            XB_SPIN(xb_ld(&bar[XB_XGEN(b.x)]) == gen, bar);
            __builtin_amdgcn_fence(__ATOMIC_ACQUIRE, "agent");
            asm volatile("s_waitcnt vmcnt(0)" ::: "memory");
        }
    }
    __syncthreads();
}

__device__ __forceinline__ void p0_transpose_item(const float* W, const float* scale, int K, int N, bf16_t* WT, LAS float* scr, int item, int lane) {
    const int nblk = N / 32, kb = item / nblk, nb = item % nblk, k0 = 64 * kb, n0 = 32 * nb;
#pragma unroll 8
    for (int i = 0; i < 32; ++i) { const int kk = 2 * i + (lane >> 5); float w = W[(size_t)(k0 + kk) * N + n0 + (lane & 31)]; if (scale) w *= scale[k0 + kk]; scr[kk * 33 + (lane & 31)] = w; }
    LDS_WAIT(); asm volatile("" ::: "memory");
    const int c = lane & 7;
#pragma unroll
    for (int j = 0; j < 4; ++j) { const int n = (lane >> 3) + 8 * j; const LAS float* s = scr + (8 * c) * 33 + n;
        v4u o; o.x = pg8::cvt_pk_bf16(s[0 * 33], s[1 * 33]); o.y = pg8::cvt_pk_bf16(s[2 * 33], s[3 * 33]); o.z = pg8::cvt_pk_bf16(s[4 * 33], s[5 * 33]); o.w = pg8::cvt_pk_bf16(s[6 * 33], s[7 * 33]);
        *(GAS v4u*)(WT + (size_t)(n0 + n) * K + k0 + 8 * c) = o; }
    LDS_WAIT(); asm volatile("" ::: "memory");
}
__device__ __forceinline__ void rms_row_to_bf16(const float* xrow, const float* g, bf16_t* orow, int lane) {
    const GAS f32x4* xr = (const GAS f32x4*)xrow + lane; const GAS f32x4* gr = (const GAS f32x4*)g + lane;
    f32x4 v[4]; float s = 0.f;
#pragma unroll
    for (int j = 0; j < 4; ++j) { v[j] = xr[64 * j]; s += (v[j].x * v[j].x + v[j].y * v[j].y) + (v[j].z * v[j].z + v[j].w * v[j].w); }
    const float r = __builtin_amdgcn_rsqf(wave_sum(s) * (1.f / DM) + EPS);
    GAS unsigned long long* o8 = (GAS unsigned long long*)orow + lane;
#pragma unroll
    for (int j = 0; j < 4; ++j) { const f32x4 gg = gr[64 * j]; o8[64 * j] = (unsigned long long)pg8::cvt_pk_bf16(v[j].x * r * gg.x, v[j].y * r * gg.y) | ((unsigned long long)pg8::cvt_pk_bf16(v[j].z * r * gg.z, v[j].w * r * gg.w) << 32); }
}
struct Args { const float* in[23]; float* out; unsigned char* ws; int ph_lo, ph_hi; };
__global__ void __launch_bounds__(NWAVES * 64, 2) mk_fwd(Args args) {
    extern __shared__ __attribute__((aligned(16))) unsigned char lds[];
    LAS unsigned char* L = (LAS unsigned char*)lds;
    volatile LAS unsigned* MISC = (volatile LAS unsigned*)(L + MISC_OFF);
    const int tid = threadIdx.x, lane = tid & 63, wave = __builtin_amdgcn_readfirstlane(tid >> 6);
    const int G = gridDim.x, bx = blockIdx.x;
    const int vcu = (G % 8 == 0) ? (bx % 8) * (G / 8) + bx / 8 : bx;
    unsigned char* ws = args.ws;
    gu32* ctl = (gu32*)(ws + WS_CTL);
    const float* x = args.in[0]; float* out = args.out;
    bf16_t* WIN = (bf16_t*)(ws + WS_WIN); bf16_t* WGLU = (bf16_t*)(ws + WS_WGLU); bf16_t* WOUT = (bf16_t*)(ws + WS_WOUT); bf16_t* W1T = (bf16_t*)(ws + WS_W1); bf16_t* W2T = (bf16_t*)(ws + WS_W2);
    float* SS1 = (float*)(ws + WS_SS1); float* SS2 = (float*)(ws + WS_SS2);
    bf16_t* XN = (bf16_t*)(ws + WS_XN); bf16_t* PROJ = (bf16_t*)(ws + WS_PROJ); bf16_t* MIX = (bf16_t*)(ws + WS_MIX); bf16_t* Z = (bf16_t*)(ws + WS_Z); bf16_t* H = (bf16_t*)(ws + WS_H);
    for (int u = tid; u < (LDS_BYTES - LDSCTL_OFF) / 4; u += NWAVES * 64) ((LAS unsigned*)(L + LDSCTL_OFF))[u] = 0u;
    __syncthreads();
    const int lo = args.ph_lo, hi = args.ph_hi;
    XcdBarrier bar; bar.bar = (unsigned*)(ctl + CW_BAR); bar.x = 0; bar.st = nullptr;
    if (hi - lo > 1) bar = xcd_barrier_post((unsigned*)(ctl + CW_BAR), MISC + 8);
#define IN(k) (lo <= (k) && (k) < hi)
#define BOTH(k) (IN(k) && IN((k) + 1))
#define GRID_BAR() xcd_barrier(bar)


    if (IN(0)) {
        LAS float* scr = (LAS float*)(L + RING_OFF + wave * 16384);
        const int gw = vcu * NWAVES + wave, NGW = G * NWAVES;
        constexpr int I_IN = (DM / 64) * (NPROJ / 32), I_GLU = (SSMW / 64) * (SSMW / 32), I_OUT = (DM / 64) * (DM / 32), I_1 = (DM / 64) * (FF / 32), I_2 = (FF / 64) * (DM / 32);
        constexpr int NITEMS = I_IN + I_GLU + I_OUT + I_1 + I_2;
        for (int it = gw; it < NITEMS; it += NGW) {
            int r = it;
            if (r < I_IN) { p0_transpose_item(args.in[2], nullptr, DM, NPROJ, WIN, scr, r, lane); continue; } r -= I_IN;
            if (r < I_GLU) { p0_transpose_item(args.in[16], nullptr, SSMW, SSMW, WGLU, scr, r, lane); continue; } r -= I_GLU;
            if (r < I_OUT) { p0_transpose_item(args.in[18], nullptr, DM, DM, WOUT, scr, r, lane); continue; } r -= I_OUT;
            if (r < I_1) { p0_transpose_item(args.in[20], args.in[19], DM, FF, W1T, scr, r, lane); continue; } r -= I_1;
            p0_transpose_item(args.in[21], nullptr, FF, DM, W2T, scr, r, lane);
        }
        for (int m = gw; m < M_TOK; m += NGW) rms_row_to_bf16(x + (size_t)m * DM, args.in[1], XN + (size_t)m * DM, lane);
        if (BOTH(0)) GRID_BAR();
    }
    if (IN(1)) {
        pg8::Gemm g{XN, WIN, M_TOK, NPROJ, DM}; pg8::StaticOrder S; S.init(M_TOK, NPROJ, G, bx);
        pg8::EpiProj E{PROJ, NPROJ};
        pg8::gemm_phase<pg8::EpiProj, pg8::StaticOrder, true, true>(L + RING_OFF, g, S, E);
        if (BOTH(1)) GRID_BAR();
    }

    if (IN(2)) {
        const float lam = expf(wave_sum(args.in[3][lane] * args.in[4][lane])) - expf(wave_sum(args.in[5][lane] * args.in[6][lane])) + LAMBDA_INIT;
        const int bh = vcu >> 3;
        for (int i = 0; i < 2; ++i) attn::attn_unit(bh >> 2, bh & 3, (vcu & 7) * 2 + i, PROJ, MIX, lam, args.in[7], (char*)lds + RING_OFF);
        if (BOTH(2)) GRID_BAR();
    }
    if (IN(3)) {
        pg8::Gemm g{Z, WGLU, M_TOK, SSMW, SSMW}; pg8::StaticOrder S; S.init(M_TOK, SSMW, G, bx);
        pg8::EpiGlu E{Z, args.in[17], MIX};
        pg8::gemm_phase<pg8::EpiGlu, pg8::StaticOrder, true, true>(L + RING_OFF, g, S, E);
        if (BOTH(3)) GRID_BAR();
    }
    if (IN(4)) {
        pg8::Gemm g{MIX, WOUT, M_TOK, DM, DM}; pg8::StaticOrder S; S.init(M_TOK, DM, G, bx);
        pg8::EpiResid<true> E{x, out, XN, SS1};
        pg8::gemm_phase<pg8::EpiResid<true>, pg8::StaticOrder, true, true>(L + RING_OFF, g, S, E);
        if (BOTH(4)) GRID_BAR();
    }
    if (IN(5)) {
        pg8::Gemm g{XN, W1T, M_TOK, FF, DM}; pg8::StaticOrder S; S.init(M_TOK, FF, G, bx);
        pg8::EpiUp E{H, FF, SS1};
        pg8::gemm_phase<pg8::EpiUp, pg8::StaticOrder, true, true>(L + RING_OFF, g, S, E);
        if (BOTH(5)) GRID_BAR();
    }
    if (IN(6)) {
        pg8::Gemm g{H, W2T, M_TOK, DM, FF}; pg8::StaticOrder S; S.init(M_TOK, DM, G, bx);
        pg8::EpiResid<false> E{out, out, nullptr, SS2};
        pg8::gemm_phase<pg8::EpiResid<false>, pg8::StaticOrder, true, true>(L + RING_OFF, g, S, E);
        if (BOTH(6)) GRID_BAR();
    }
    if (IN(7)) {
        const float* gf = args.in[22];
        const int gw = vcu * NWAVES + wave, NGW = G * NWAVES;
        for (int m = gw; m < M_TOK; m += NGW) {
            const float r = pg8::rstd16(SS2, m);
            GAS f32x4* o = (GAS f32x4*)(out + (size_t)m * DM) + lane; const GAS f32x4* gp = (const GAS f32x4*)gf + lane;
#pragma unroll
            for (int j = 0; j < 4; ++j) { f32x4 v = o[64 * j]; const f32x4 gg = gp[64 * j]; v = v * r * gg; o[64 * j] = v; }
        }
    }
#undef IN
#undef BOTH
#undef GRID_BAR
}
__global__ void __launch_bounds__(256) k_transpose_w(const float* __restrict__ W, const float* __restrict__ scale, bf16_t* __restrict__ WT, int K, int N) {
    __shared__ float t[32][33];
    const int k0 = blockIdx.y * 32, n0 = blockIdx.x * 32, tx = threadIdx.x & 31, ty = threadIdx.x >> 5;
    for (int i = ty; i < 32; i += 8) { float s = scale ? scale[k0 + i] : 1.f; t[i][tx] = W[(size_t)(k0 + i) * N + n0 + tx] * s; }
    __syncthreads();
    for (int i = ty; i < 32; i += 8) WT[(size_t)(n0 + i) * K + k0 + tx] = f2bf(t[tx][i]);
}

__global__ void __launch_bounds__(256) k_rmsnorm_bf16(const float* __restrict__ x, const float* __restrict__ g, bf16_t* __restrict__ out) {
    const int row = blockIdx.x * 4 + (threadIdx.x >> 6), lane = threadIdx.x & 63;
    const float* xr = x + (size_t)row * DM; float v[16]; float s = 0.f;
#pragma unroll
    for (int j = 0; j < 16; ++j) { v[j] = xr[lane + 64 * j]; s += v[j] * v[j]; }
    const float r = rsqrtf(wave_sum(s) * (1.f / DM) + EPS);
#pragma unroll
    for (int j = 0; j < 16; ++j) out[(size_t)row * DM + lane + 64 * j] = f2bf(v[j] * r * g[lane + 64 * j]);
}

__global__ void __launch_bounds__(256) k_rowss(const float* __restrict__ h, float* __restrict__ ss) {
    const int row = blockIdx.x * 4 + (threadIdx.x >> 6), lane = threadIdx.x & 63;
    const float* xr = h + (size_t)row * DM; float s = 0.f;
#pragma unroll
    for (int j = 0; j < 16; ++j) { float v = xr[lane + 64 * j]; s += v * v; }
    s = wave_sum(s);
    if (lane < 16) ss[(size_t)row * 16 + lane] = lane == 0 ? s : 0.f;
}
__device__ __forceinline__ float row_rstd(const float* ss, int row) {
    float s = 0.f;
#pragma unroll
    for (int i = 0; i < 16; ++i) s += ss[(size_t)row * 16 + i];
    return rsqrtf(s * (1.f / DM) + EPS);
}
__global__ void __launch_bounds__(256) k_final(float* __restrict__ out, const float* __restrict__ ss, const float* __restrict__ g) {
    const int row = blockIdx.x * 4 + (threadIdx.x >> 6), lane = threadIdx.x & 63;
    const float r = row_rstd(ss, row);
    float* xr = out + (size_t)row * DM;
#pragma unroll
    for (int j = 0; j < 16; ++j) xr[lane + 64 * j] = xr[lane + 64 * j] * r * g[lane + 64 * j];
}

enum { EPI_PROJ = 0, EPI_GLU = 1, EPI_OUT = 2, EPI_UP = 3, EPI_DOWN = 4 };
struct EpiArgs { bf16_t* obf; float* of32; const float* x; const float* vec; const bf16_t* zin; const float* ss; int ldo; };
template <int EPI> __device__ __forceinline__ void epi_elem(const EpiArgs& e, int row, int col, float acc) {
    if (EPI == EPI_PROJ) e.obf[(size_t)row * e.ldo + col] = f2bf(acc);
    else if (EPI == EPI_GLU) { const float z = bf2f(e.zin[(size_t)row * SSMW + col]); const float s = 1.f / (1.f + __expf(-(acc + e.vec[col]))); e.obf[(size_t)row * e.ldo + SSMW + col] = f2bf(z * s); }
    else if (EPI == EPI_OUT) { const float h = e.x[(size_t)row * DM + col] + acc; e.of32[(size_t)row * DM + col] = h; e.obf[(size_t)row * DM + col] = f2bf(h); }
    else if (EPI == EPI_UP) { float v = acc * row_rstd(e.ss, row); v = fmaxf(v, 0.f); e.obf[(size_t)row * e.ldo + col] = f2bf(v * v); }
    else if (EPI == EPI_DOWN) { e.of32[(size_t)row * DM + col] += acc; }
}
template <int EPI> __global__ void __launch_bounds__(256) k_gemm_naive(const bf16_t* __restrict__ A, const bf16_t* __restrict__ Bt, int K, EpiArgs e) {
    __shared__ float As[64][33], Bs[64][33];
    const int tid = threadIdx.x, tx = tid & 15, ty = tid >> 4, m0 = blockIdx.y * 64, n0 = blockIdx.x * 64;
    float acc[4][4] = {};
    for (int k0 = 0; k0 < K; k0 += 32) {
        for (int i = tid; i < 64 * 32; i += 256) { const int r = i >> 5, c = i & 31; As[r][c] = bf2f(A[(size_t)(m0 + r) * K + k0 + c]); Bs[r][c] = bf2f(Bt[(size_t)(n0 + r) * K + k0 + c]); }
        __syncthreads();
#pragma unroll 8
        for (int k = 0; k < 32; ++k) { float a[4], b[4];
#pragma unroll
            for (int i = 0; i < 4; ++i) { a[i] = As[ty * 4 + i][k]; b[i] = Bs[tx * 4 + i][k]; }
#pragma unroll
            for (int i = 0; i < 4; ++i)
#pragma unroll
                for (int j = 0; j < 4; ++j) acc[i][j] = fmaf(a[i], b[j], acc[i][j]); }
        __syncthreads();
    }
#pragma unroll
    for (int i = 0; i < 4; ++i)
#pragma unroll
        for (int j = 0; j < 4; ++j) epi_elem<EPI>(e, m0 + ty * 4 + i, n0 + tx * 4 + j, acc[i][j]);
}

__global__ void __launch_bounds__(256) k_attn_naive(const bf16_t* __restrict__ proj, bf16_t* __restrict__ mix, const float* __restrict__ lq1, const float* __restrict__ lk1,
                                                    const float* __restrict__ lq2, const float* __restrict__ lk2, const float* __restrict__ subg) {
    __shared__ float abuf[4][SEQ];
    const int w = threadIdx.x >> 6, lane = threadIdx.x & 63;
    const int i = blockIdx.x * 4 + w, h = blockIdx.y, b = blockIdx.z;
    float* a = abuf[w];
    float d1 = 0.f, d2 = 0.f;
    d1 = wave_sum(lq1[lane] * lk1[lane]); d2 = wave_sum(lq2[lane] * lk2[lane]);
    const float lam = expf(d1) - expf(d2) + LAMBDA_INIT;
    const float slope = exp2f(-8.0f * (float)(h + 1) / (float)NH);
    const size_t rowq = (size_t)(b * SEQ + i) * NPROJ;
    for (int c = 0; c < 2; ++c) {
        float q[64];
#pragma unroll
        for (int d = 0; d < 64; ++d) q[d] = bf2f(proj[rowq + h * 128 + c * 64 + d]);
        float sc[32]; float mx = -3.0e38f;
#pragma unroll
        for (int t = 0; t < 32; ++t) { const int j = lane + 64 * t; const bf16_t* kr = proj + (size_t)(b * SEQ + j) * NPROJ + 512 + h * 128 + c * 64;
            float s = 0.f;
#pragma unroll
            for (int d = 0; d < 64; ++d) s = fmaf(q[d], bf2f(kr[d]), s);
            s = s * 0.125f - slope * fabsf((float)(i - j)); sc[t] = s; mx = fmaxf(mx, s); }
        mx = wave_max(mx); float l = 0.f;
#pragma unroll
        for (int t = 0; t < 32; ++t) { sc[t] = expf(sc[t] - mx); l += sc[t]; }
        l = wave_sum(l); const float il = 1.f / l;
#pragma unroll
        for (int t = 0; t < 32; ++t) { const int j = lane + 64 * t; if (c == 0) a[j] = sc[t] * il; else a[j] -= lam * sc[t] * il; }
    }
    __syncthreads();
    float o0 = 0.f, o1 = 0.f;
    for (int j = 0; j < SEQ; ++j) { const bf16_t* vr = proj + (size_t)(b * SEQ + j) * NPROJ + 1024 + h * 128; const float aj = a[j]; o0 = fmaf(aj, bf2f(vr[lane]), o0); o1 = fmaf(aj, bf2f(vr[64 + lane]), o1); }
    const float ms = wave_sum(o0 * o0 + o1 * o1) * (1.f / 128.f); const float r = rsqrtf(ms + EPS) * (1.f - LAMBDA_INIT);
    bf16_t* orow = mix + (size_t)(b * SEQ + i) * DM + h * 128;
    orow[lane] = f2bf(o0 * r * subg[lane]); orow[64 + lane] = f2bf(o1 * r * subg[64 + lane]);
}

__global__ void __launch_bounds__(64) k_ssm_naive(const bf16_t* __restrict__ proj, float* __restrict__ Y, const float* __restrict__ lam_re, const float* __restrict__ lam_im, const float* __restrict__ log_dt,
                                                  const float* __restrict__ b_re, const float* __restrict__ b_im, const float* __restrict__ c_re, const float* __restrict__ c_im) {
    __shared__ float xs[2][64]; __shared__ float cs[2][64][17];
    const int g = blockIdx.x, b = blockIdx.y, p = threadIdx.x;
    for (int dir = 0; dir < 2; ++dir) {
        const int pg = (dir * NG + g);
        const float dt = expf(log_dt[pg]), lr = lam_re[pg * NP + p], li = lam_im[pg * NP + p];
        const float mag = expf(lr * dt), ang = li * dt, ar = mag * cosf(ang), ai = mag * sinf(ang), nr = ar - 1.f, den = lr * lr + li * li;
        const float cr = (nr * lr + ai * li) / den, ci = (ai * lr - nr * li) / den;
        float bbr[16], bbi[16];
#pragma unroll
        for (int h = 0; h < 16; ++h) { const float br = b_re[(size_t)(pg * NP + p) * GC + h], bi = b_im[(size_t)(pg * NP + p) * GC + h]; bbr[h] = cr * br - ci * bi; bbi[h] = cr * bi + ci * br; }
        __syncthreads();
        for (int h = 0; h < 16; ++h) { cs[0][p][h] = c_re[(size_t)(pg * GC + h) * NP + p]; cs[1][p][h] = c_im[(size_t)(pg * GC + h) * NP + p]; }
        __syncthreads();
        float xr = 0.f, xi = 0.f;
        for (int s = 0; s < SEQ; ++s) {
            const int t = dir == 0 ? s : SEQ - 1 - s;
            const bf16_t* ur = proj + (size_t)(b * SEQ + t) * NPROJ + 1536 + g * GC;
            float bur = 0.f, bui = 0.f;
#pragma unroll
            for (int h = 0; h < 16; ++h) { const float u = bf2f(ur[h]); bur = fmaf(bbr[h], u, bur); bui = fmaf(bbi[h], u, bui); }
            const float nxr = ar * xr - ai * xi + bur, nxi = ar * xi + ai * xr + bui; xr = nxr; xi = nxi;
            xs[0][p] = xr; xs[1][p] = xi;
            __syncthreads();
            if (p < 16) { float y = 0.f;
                for (int q = 0; q < 64; ++q) y += cs[0][q][p] * xs[0][q] - cs[1][q][p] * xs[1][q];
                float* yp = Y + (size_t)(b * SEQ + t) * SSMW + g * GC + p; if (dir == 0) *yp = y; else *yp += y; }
            __syncthreads();
        }
    }
}
__global__ void __launch_bounds__(256) k_ssm_post(const float* __restrict__ Y, const bf16_t* __restrict__ proj, const float* __restrict__ dskip, bf16_t* __restrict__ Z) {
    const size_t idx = (size_t)blockIdx.x * 256 + threadIdx.x; const int row = (int)(idx / SSMW), ch = (int)(idx % SSMW);
    const float u = bf2f(proj[(size_t)row * NPROJ + 1536 + ch]); const float y = Y[idx] + dskip[ch] * u;
    Z[idx] = f2bf(0.5f * y * (1.f + erff(y * 0.70710678118654752f)));
}

static void launch_mk(Args a, int lo, int hi, int grid, hipStream_t stream) {
    a.ph_lo = lo; a.ph_hi = hi;
    if (hi - lo > 1) { void* kargs[] = {&a}; hipError_t e = hipLaunchCooperativeKernel((const void*)mk_fwd, dim3(grid), dim3(NWAVES * 64), kargs, LDS_BYTES, stream);
        if (e != hipSuccess) fprintf(stderr, "cooperative launch failed: %s (grid %d)\n", hipGetErrorString(e), grid); }
    else hipLaunchKernelGGL(mk_fwd, dim3(grid), dim3(NWAVES * 64), LDS_BYTES, stream, a);
}
extern "C" void kernel_launch(void* const* d_in, const int* in_sizes, int n_in, void* d_out, int out_size, void* d_ws, size_t ws_size, hipStream_t stream) {
    (void)in_sizes; (void)n_in; (void)out_size; (void)ws_size;
    static int grid = 0;
    if (grid == 0) {
        int dev = 0, cus = 0, per_cu = 0;
        (void)hipGetDevice(&dev); (void)hipDeviceGetAttribute(&cus, hipDeviceAttributeMultiprocessorCount, dev);
        if (hipFuncSetAttribute((const void*)mk_fwd, hipFuncAttributeMaxDynamicSharedMemorySize, LDS_BYTES) != hipSuccess) { fprintf(stderr, "hipFuncSetAttribute failed\n"); grid = -1; return; }
        (void)hipOccupancyMaxActiveBlocksPerMultiprocessor(&per_cu, (const void*)mk_fwd, NWAVES * 64, LDS_BYTES);
        (void)hipGetLastError();
        if (per_cu < 1) per_cu = 1;
        grid = cus * 1;
        if (grid != 256) fprintf(stderr, "kernel_launch: %d CUs (occupancy query %d/CU)\n", cus, per_cu);
    }
    if (grid < 0) return;
    const float* x = (const float*)d_in[0]; const float* g1 = (const float*)d_in[1]; const float* w_in = (const float*)d_in[2];
    const float* lq1 = (const float*)d_in[3]; const float* lk1 = (const float*)d_in[4]; const float* lq2 = (const float*)d_in[5]; const float* lk2 = (const float*)d_in[6];
    const float* subg = (const float*)d_in[7]; const float* s_lre = (const float*)d_in[8]; const float* s_lim = (const float*)d_in[9]; const float* s_ldt = (const float*)d_in[10];
    const float* s_bre = (const float*)d_in[11]; const float* s_bim = (const float*)d_in[12]; const float* s_cre = (const float*)d_in[13]; const float* s_cim = (const float*)d_in[14];
    const float* s_d = (const float*)d_in[15]; const float* w_glu = (const float*)d_in[16]; const float* w_out = (const float*)d_in[18];
    const float* g2 = (const float*)d_in[19]; const float* w1 = (const float*)d_in[20]; const float* w2 = (const float*)d_in[21];
    unsigned char* ws = (unsigned char*)d_ws;
    bf16_t* WIN = (bf16_t*)(ws + WS_WIN); bf16_t* WGLU = (bf16_t*)(ws + WS_WGLU); bf16_t* WOUT = (bf16_t*)(ws + WS_WOUT); bf16_t* W1T = (bf16_t*)(ws + WS_W1); bf16_t* W2T = (bf16_t*)(ws + WS_W2);
    bf16_t* XN = (bf16_t*)(ws + WS_XN); bf16_t* PROJ = (bf16_t*)(ws + WS_PROJ); bf16_t* MIX = (bf16_t*)(ws + WS_MIX); bf16_t* Z = (bf16_t*)(ws + WS_Z); float* Y = (float*)(ws + WS_Y);
    (void)hipMemsetAsync(ws + WS_CTL, 0, CTL_ZERO_BYTES, stream);
    Args a{};
    for (int i = 0; i < 23; ++i) a.in[i] = (const float*)d_in[i];
    a.out = (float*)d_out; a.ws = ws;

    launch_mk(a, 0, 1, grid, stream);
    launch_mk(a, 1, 2, grid, stream);
    launch_mk(a, 2, 3, grid, stream);
    k_ssm_naive<<<dim3(NG, BATCH), 64, 0, stream>>>(PROJ, Y, s_lre, s_lim, s_ldt, s_bre, s_bim, s_cre, s_cim);
    k_ssm_post<<<M_TOK * SSMW / 256, 256, 0, stream>>>(Y, PROJ, s_d, Z);
    launch_mk(a, 3, 8, grid, stream);
}
```

```cpp
#include <hip/hip_runtime.h>
#include <cstdio>
#include <cstdint>
#include <cmath>

typedef unsigned short bf16_t;

constexpr int BATCH = 8, SEQ = 2048, DM = 1024, M_TOK = BATCH * SEQ;
constexpr int NPROJ = 2048, FF = 4096, NH = 4, VD = 128, QKD = 64, SSMW = 512, NG = 32, GC = 16, NP = 64;
constexpr float EPS = 1e-6f;
constexpr float LAMBDA_INIT = 0.2f;

constexpr size_t MiB = 1u << 20;
constexpr size_t WS_WIN = 2 * MiB, WS_WGLU = 6 * MiB, WS_WOUT = 7 * MiB, WS_W1 = 10 * MiB, WS_W2 = 18 * MiB;
constexpr size_t WS_KC = 26 * MiB, WS_WST = 27 * MiB, WS_WCY = 31 * MiB, WS_A16 = 35 * MiB;
constexpr size_t WS_SS1 = 36 * MiB, WS_SS2 = 37 * MiB;
constexpr size_t WS_XN = 40 * MiB, WS_PROJ = 72 * MiB, WS_MIX = 136 * MiB, WS_Z = 168 * MiB, WS_H = 72 * MiB, WS_Y = 200 * MiB;

__device__ __forceinline__ float bf2f(bf16_t v) { return __uint_as_float((unsigned)v << 16); }
__device__ __forceinline__ bf16_t f2bf(float f) { unsigned u = __float_as_uint(f); return (bf16_t)((u + 0x7fffu + ((u >> 16) & 1u)) >> 16); }
__device__ __forceinline__ float wave_sum(float v) {
#pragma unroll
    for (int o = 1; o < 64; o <<= 1) v += __shfl_xor(v, o);
    return v;
}
__device__ __forceinline__ float wave_max(float v) {
#pragma unroll
    for (int o = 1; o < 64; o <<= 1) v = fmaxf(v, __shfl_xor(v, o));
    return v;
}

namespace pg8 {
#define PG8_LAS __attribute__((address_space(3)))
typedef unsigned short bf16_t;
typedef short bf16x8 __attribute__((ext_vector_type(8)));
typedef float f32x4 __attribute__((ext_vector_type(4)));
typedef unsigned u32x4 __attribute__((ext_vector_type(4)));
constexpr int BM = 256, BK = 64, HALF = 128, HTB = HALF * BK * 2  , STAGE_BYTES = 8 * HTB, NXCD = 8, WGM = 8;

__host__ __device__ __forceinline__ int lds_byte(int r, int c) { const int st = (r >> 4) * 2 + (c >> 5), rr = r & 15, cc = c & 31, ob = rr * 64 + cc * 2; return st * 1024 + (ob ^ (((ob >> 9) & 1) << 5)); }
__host__ __device__ __forceinline__ void stage_rc(int b, int& R, int& C) { const int st = b / 1024, sb = b % 1024, swz = sb ^ (((sb >> 9) & 1) << 5); R = (st >> 1) * 16 + swz / 64; C = (st & 1) * 32 + (swz % 64) / 2; }
__host__ __device__ __forceinline__ int perm32(int rho) { const int n = rho >> 4, i = rho & 15; return 8 * (i >> 2) + 4 * n + (i & 3); }

struct Unit { int pm, pn; };
struct Gemm { const bf16_t* A; const bf16_t* Bt; int M, N, K; };

struct StaticOrder {
    int nM, nN, nwg, G, c;
    __host__ __device__ void init(int M, int N, int G_, int c_) { nM = M / BM; nN = N / BM; nwg = nM * nN; G = G_; c = c_; }
    __host__ __device__ bool next(int i, Unit& u) const {
        const long L = (long)i * G + c; if (L >= nwg) return false;
        int wgid = (int)L; { const int q = nwg / NXCD, r = nwg % NXCD, xcd = wgid % NXCD, off = wgid / NXCD; wgid = (xcd < r ? xcd * (q + 1) : r * (q + 1) + (xcd - r) * q) + off; }
        const int nig = WGM * nN, gid = wgid / nig, fm = gid * WGM, gsz = (nM - fm) < WGM ? (nM - fm) : WGM;
        u.pm = fm + ((wgid % nig) % gsz); u.pn = (wgid % nig) / gsz; return true;
    }
    __device__ __forceinline__ void a_ready(const Unit&) const {}
    __device__ __forceinline__ void done(const Unit&) const {}
};

typedef float cvt_f32x2_t __attribute__((ext_vector_type(2))); typedef __bf16 cvt_bf16x2_t __attribute__((ext_vector_type(2)));
__device__ __forceinline__ unsigned cvt_pk_safe(float lo, float hi) { cvt_f32x2_t v = {lo, hi}; cvt_bf16x2_t b = __builtin_convertvector(v, cvt_bf16x2_t); return __builtin_bit_cast(unsigned, b); }
__device__ __forceinline__ unsigned cvt_pk_bf16(float lo, float hi) { unsigned r; asm volatile("v_cvt_pk_bf16_f32 %0, %1, %2" : "=v"(r) : "v"(lo), "v"(hi)); return r; }
typedef float f32x2 __attribute__((ext_vector_type(2)));
__device__ __forceinline__ f32x2 gelu_pk(f32x2 v) {
    const f32x2 av = __builtin_elementwise_abs(v), d = av * 0.2316418882f + 1.0f;
    f32x2 t; t.x = __builtin_amdgcn_rcpf(d.x); t.y = __builtin_amdgcn_rcpf(d.y);
    f32x2 q = t * 0.5307027145f + (-0.7265760135f); q = q * t + 0.7107068705f; q = q * t + (-0.142248368f); q = q * t + 0.127414796f; q = q * t;
    const f32x2 s = (v * v) * (-0.72134752044f);
    f32x2 e; e.x = __builtin_amdgcn_exp2f(s.x); e.y = __builtin_amdgcn_exp2f(s.y);
    const f32x2 m = v * (q * e), r = v - m;
    f32x2 o; o.x = v.x < 0.f ? m.x : r.x; o.y = v.y < 0.f ? m.y : r.y; return o;
}
typedef unsigned u32x2 __attribute__((ext_vector_type(2)));
constexpr float RMS_EPS = 1e-6f;
__device__ __forceinline__ float rstd16(const float* ss, int row) {
    const f32x4* p = (const f32x4*)(ss + (size_t)row * 16); const f32x4 a = p[0], b = p[1], c = p[2], d = p[3];
    const float s = ((a[0] + a[1]) + (a[2] + a[3])) + ((b[0] + b[1]) + (b[2] + b[3])) + ((c[0] + c[1]) + (c[2] + c[3])) + ((d[0] + d[1]) + (d[2] + d[3]));
    return __builtin_amdgcn_rsqf(s * (1.0f / 1024.0f) + RMS_EPS);
}
struct EpiProj {
    static constexpr bool PERM = true, AFTER_DRAIN = false;
    bf16_t* O; int ldc;
    __device__ __forceinline__ void operator()(const f32x4 (&acc)[2][2][4][2], const Unit& u, int wr, int wc, int fr, int fq) const {
        const int row0 = u.pm * BM + wr * 64 + fr, col0 = u.pn * BM + wc * 32 + 8 * fq;
#pragma unroll
        for (int ai = 0; ai < 2; ++ai)
#pragma unroll
            for (int m = 0; m < 4; ++m) { bf16_t* rowp = O + (size_t)(row0 + ai * HALF + m * 16) * ldc + col0;
#pragma unroll
                for (int bj = 0; bj < 2; ++bj) { const f32x4 v0 = acc[ai][bj][m][0], v1 = acc[ai][bj][m][1];
                    u32x4 w; w.x = cvt_pk_bf16(v0[0], v0[1]); w.y = cvt_pk_bf16(v0[2], v0[3]); w.z = cvt_pk_bf16(v1[0], v1[1]); w.w = cvt_pk_bf16(v1[2], v1[3]);
                    *(u32x4*)(rowp + bj * HALF) = w; } }
    }
};
struct EpiGlu {
    static constexpr bool PERM = true, AFTER_DRAIN = false;
    const bf16_t* Z; const float* bias; bf16_t* O;
    __device__ __forceinline__ void operator()(const f32x4 (&acc)[2][2][4][2], const Unit& u, int wr, int wc, int fr, int fq) const {
        const int row0 = u.pm * BM + wr * 64 + fr, col0 = u.pn * BM + wc * 32 + 8 * fq;
        f32x4 bv[2][2];
#pragma unroll
        for (int bj = 0; bj < 2; ++bj)
#pragma unroll
            for (int n = 0; n < 2; ++n) bv[bj][n] = *(const f32x4*)(bias + col0 + bj * HALF + 4 * n);
#pragma unroll
        for (int ai = 0; ai < 2; ++ai)
#pragma unroll
            for (int m = 0; m < 4; ++m) { const size_t row = (size_t)(row0 + ai * HALF + m * 16);
#pragma unroll
                for (int bj = 0; bj < 2; ++bj) { const u32x4 zz = *(const u32x4*)(Z + row * 512 + col0 + bj * HALF);
                    float z[8]; z[0] = __uint_as_float(zz.x << 16); z[1] = __uint_as_float(zz.x & 0xffff0000u); z[2] = __uint_as_float(zz.y << 16); z[3] = __uint_as_float(zz.y & 0xffff0000u);
                    z[4] = __uint_as_float(zz.z << 16); z[5] = __uint_as_float(zz.z & 0xffff0000u); z[6] = __uint_as_float(zz.w << 16); z[7] = __uint_as_float(zz.w & 0xffff0000u);
                    float o[8];
#pragma unroll
                    for (int n = 0; n < 2; ++n)
#pragma unroll
                        for (int i = 0; i < 4; ++i) { const float t = acc[ai][bj][m][n][i] + bv[bj][n][i]; const float s = __builtin_amdgcn_rcpf(1.0f + __builtin_amdgcn_exp2f(-1.4426950408889634f * t)); o[4 * n + i] = z[4 * n + i] * s; }
                    u32x4 w; w.x = cvt_pk_bf16(o[0], o[1]); w.y = cvt_pk_bf16(o[2], o[3]); w.z = cvt_pk_bf16(o[4], o[5]); w.w = cvt_pk_bf16(o[6], o[7]);
                    *(u32x4*)(O + row * 1024 + 512 + col0 + bj * HALF) = w; } }
    }
};
template <bool WRITE_BF> struct EpiResid {
    static constexpr bool PERM = false, AFTER_DRAIN = false;
    const float* base; float* out; bf16_t* hb; float* ss;
    __device__ __forceinline__ void operator()(const f32x4 (&acc)[2][2][4][2], const Unit& u, int wr, int wc, int fr, int fq) const {
        const int row0 = u.pm * BM + wr * 64 + fr, col0 = u.pn * BM + wc * 32 + 4 * fq;
#pragma unroll
        for (int ai = 0; ai < 2; ++ai)
#pragma unroll
            for (int m = 0; m < 4; ++m) { const int row = row0 + ai * HALF + m * 16; const size_t off = (size_t)row * 1024 + col0; float s = 0.f;
#pragma unroll
                for (int bj = 0; bj < 2; ++bj)
#pragma unroll
                    for (int n = 0; n < 2; ++n) { const f32x4 h = *(const f32x4*)(base + off + bj * HALF + n * 16) + acc[ai][bj][m][n];
                        *(f32x4*)(out + off + bj * HALF + n * 16) = h; s += (h[0] * h[0] + h[1] * h[1]) + (h[2] * h[2] + h[3] * h[3]);
                        if (WRITE_BF) { u32x2 w; w.x = cvt_pk_bf16(h[0], h[1]); w.y = cvt_pk_bf16(h[2], h[3]); *(u32x2*)(hb + off + bj * HALF + n * 16) = w; } }
                s += __shfl_xor(s, 16); s += __shfl_xor(s, 32);
                if (fq == 0) ss[(size_t)row * 16 + u.pn * 4 + wc] = s; }
    }
};
struct EpiUp {
    static constexpr bool PERM = true, AFTER_DRAIN = false;
    bf16_t* O; int ldc; const float* ss;
    __device__ __forceinline__ void operator()(const f32x4 (&acc)[2][2][4][2], const Unit& u, int wr, int wc, int fr, int fq) const {
        const int row0 = u.pm * BM + wr * 64 + fr, col0 = u.pn * BM + wc * 32 + 8 * fq;
#pragma unroll
        for (int ai = 0; ai < 2; ++ai)
#pragma unroll
            for (int m = 0; m < 4; ++m) { const int row = row0 + ai * HALF + m * 16; const float r = rstd16(ss, row); bf16_t* rowp = O + (size_t)row * ldc + col0;
#pragma unroll
                for (int bj = 0; bj < 2; ++bj) { f32x4 v0 = acc[ai][bj][m][0] * r, v1 = acc[ai][bj][m][1] * r;
#pragma unroll
                    for (int i = 0; i < 4; ++i) { const float a = fmaxf(v0[i], 0.f), b = fmaxf(v1[i], 0.f); v0[i] = a * a; v1[i] = b * b; }
                    u32x4 w; w.x = cvt_pk_bf16(v0[0], v0[1]); w.y = cvt_pk_bf16(v0[2], v0[3]); w.z = cvt_pk_bf16(v1[0], v1[1]); w.w = cvt_pk_bf16(v1[2], v1[3]);
                    *(u32x4*)(rowp + bj * HALF) = w; } }
    }
};
template <class Epi, class Sched, bool ALIGN_EPI = false, bool SP2 = false>
__device__ __forceinline__ void gemm_phase(PG8_LAS unsigned char* lds, const Gemm g, const Sched& S, const Epi& E) {
    const int tid = threadIdx.x, wid = __builtin_amdgcn_readfirstlane(tid >> 6), lane = tid & 63, wr = wid >> 2, wc = wid & 3, fr = lane & 15, fq = lane >> 4;
    const int K = g.K, nt = K / BK;
    unsigned voffA[2], voffB[2];
#pragma unroll
    for (int i = 0; i < 2; ++i) { int R, C; stage_rc(tid * 16 + i * 8192, R, C); const int Rb = Epi::PERM ? ((R & ~31) + perm32(R & 31)) : R;
        voffA[i] = (unsigned)(R * K + C) * 2u; voffB[i] = (unsigned)(Rb * K + C) * 2u; }
    const size_t kstep = (size_t)(BK * 2);
    const size_t hstep = (size_t)HALF * K * 2;
    const size_t tstep = 2 * hstep;
    const unsigned ldsw = (unsigned)wid * 1024u;
    const int aoff = lds_byte(wr * 64 + fr, fq * 8), boff = lds_byte(wc * 32 + fr, fq * 8);
#define PG8_SA(b, h) (((b) * 2 + (h)) * HTB)
#define PG8_SB(b, h) ((4 + (b) * 2 + (h)) * HTB)
#define PG8_STAGE(bufoff, gbase, voff) do { _Pragma("unroll") for (int _i = 0; _i < 2; ++_i) \
        __builtin_amdgcn_global_load_lds((const unsigned*)((const char*)(gbase) + (voff)[_i]), (PG8_LAS unsigned*)(lds + (bufoff) + ldsw + _i * 8192), 16, 0, 0); } while (0)
#define PG8_LDA(dst, b, h) do { _Pragma("unroll") for (int m = 0; m < 4; ++m) _Pragma("unroll") for (int k = 0; k < 2; ++k) dst[m][k] = *(const PG8_LAS bf16x8*)(lds + PG8_SA(b, h) + aoff + m * 2048 + k * 1024); } while (0)
#define PG8_LDB(dst, b, h) do { _Pragma("unroll") for (int n = 0; n < 2; ++n) _Pragma("unroll") for (int k = 0; k < 2; ++k) dst[n][k] = *(const PG8_LAS bf16x8*)(lds + PG8_SB(b, h) + boff + n * 2048 + k * 1024); } while (0)
#define PG8_MMA(ai, bj, At, Bt) do { __builtin_amdgcn_s_setprio(1); _Pragma("unroll") for (int m = 0; m < 4; ++m) _Pragma("unroll") for (int n = 0; n < 2; ++n) _Pragma("unroll") for (int k = 0; k < 2; ++k) \
        acc[ai][bj][m][n] = __builtin_amdgcn_mfma_f32_16x16x32_bf16(Bt[n][k], At[m][k], acc[ai][bj][m][n], 0, 0, 0); __builtin_amdgcn_s_setprio(0); } while (0)
#define PG8_WAIT_V(n) asm volatile("s_waitcnt vmcnt(" #n ")" ::: "memory")
#define PG8_WAIT_L(n) asm volatile("s_waitcnt lgkmcnt(" #n ")" ::: "memory")
#define PG8_BAR __builtin_amdgcn_s_barrier()
#define PG8_SCHED __builtin_amdgcn_sched_barrier(0)
    Unit cur, nxt; int ui = 0;
    if (!S.next(0, cur)) return;
    f32x4 acc[2][2][4][2];
#pragma unroll
    for (int a = 0; a < 2; ++a)
#pragma unroll
        for (int b = 0; b < 2; ++b)
#pragma unroll
            for (int m = 0; m < 4; ++m)
#pragma unroll
                for (int n = 0; n < 2; ++n) acc[a][b][m][n] = (f32x4){0.f, 0.f, 0.f, 0.f};
    bf16x8 At[4][2], B0[2][2], B1[2][2];
    const char* cA = (const char*)g.A + (size_t)cur.pm * tstep; const char* cB = (const char*)g.Bt + (size_t)cur.pn * tstep;
    S.a_ready(cur);
    if constexpr (SP2) {
        PG8_STAGE(PG8_SB(0, 0), cB, voffB); PG8_STAGE(PG8_SB(0, 1), cB + hstep, voffB); PG8_STAGE(PG8_SA(0, 0), cA, voffA); PG8_STAGE(PG8_SA(0, 1), cA + hstep, voffA);
        if (wr == 1) PG8_BAR;
        PG8_WAIT_V(2); PG8_BAR;
        PG8_STAGE(PG8_SB(1, 0), cB + kstep, voffB); PG8_STAGE(PG8_SA(1, 0), cA + kstep, voffA); PG8_STAGE(PG8_SB(1, 1), cB + hstep + kstep, voffB);
        PG8_WAIT_V(6); PG8_BAR;
    } else {
        PG8_STAGE(PG8_SB(0, 0), cB, voffB); PG8_STAGE(PG8_SA(0, 0), cA, voffA); PG8_STAGE(PG8_SB(0, 1), cB + hstep, voffB); PG8_STAGE(PG8_SA(0, 1), cA + hstep, voffA);
        if (wr == 1) PG8_BAR;
        PG8_WAIT_V(4); PG8_BAR;
        PG8_STAGE(PG8_SB(1, 0), cB + kstep, voffB); PG8_STAGE(PG8_SA(1, 0), cA + kstep, voffA); PG8_STAGE(PG8_SB(1, 1), cB + hstep + kstep, voffB);
        PG8_WAIT_V(6); PG8_BAR;
    }
    for (;;) {
        const bool has_next = S.next(ui + 1, nxt);
        const char* nA = has_next ? (const char*)g.A + (size_t)nxt.pm * tstep : cA; const char* nB = has_next ? (const char*)g.Bt + (size_t)nxt.pn * tstep : cB;
        for (int t = 0; t < nt; t += 2) {
            const bool last = (t == nt - 2);
            const char* a1 = cA + (size_t)(t + 1) * kstep;
            const char* a2 = last ? nA : cA + (size_t)(t + 2) * kstep; const char* b2 = last ? nB : cB + (size_t)(t + 2) * kstep;
            const char* a3 = a2 + kstep; const char* b3 = b2 + kstep;
            if (last && has_next) S.a_ready(nxt);
            if constexpr (SP2) {
            PG8_LDB(B0, 0, 0); PG8_LDB(B1, 0, 1); PG8_SCHED; PG8_LDA(At, 0, 0); PG8_STAGE(PG8_SA(1, 1), a1 + hstep, voffA);
            PG8_WAIT_V(8); PG8_WAIT_L(0); PG8_BAR; PG8_MMA(0, 0, At, B0); PG8_MMA(0, 1, At, B1); PG8_BAR; PG8_SCHED;
            PG8_LDA(At, 0, 1); PG8_STAGE(PG8_SB(0, 0), b2, voffB); PG8_STAGE(PG8_SB(0, 1), b2 + hstep, voffB); PG8_STAGE(PG8_SA(0, 0), a2, voffA);
            PG8_WAIT_V(8); PG8_WAIT_L(0); PG8_BAR; PG8_MMA(1, 0, At, B0); PG8_MMA(1, 1, At, B1); PG8_BAR; PG8_SCHED;
            PG8_LDB(B0, 1, 0); PG8_LDB(B1, 1, 1); PG8_SCHED; PG8_LDA(At, 1, 0); PG8_STAGE(PG8_SA(0, 1), a2 + hstep, voffA);
            PG8_WAIT_V(8); PG8_WAIT_L(0); PG8_BAR; PG8_MMA(0, 0, At, B0); PG8_MMA(0, 1, At, B1); PG8_BAR; PG8_SCHED;
            PG8_LDA(At, 1, 1); PG8_STAGE(PG8_SB(1, 0), b3, voffB); PG8_STAGE(PG8_SB(1, 1), b3 + hstep, voffB); PG8_STAGE(PG8_SA(1, 0), a3, voffA);
            PG8_WAIT_V(8); PG8_WAIT_L(0); PG8_BAR; PG8_MMA(1, 0, At, B0); PG8_MMA(1, 1, At, B1); PG8_BAR; PG8_SCHED;
            } else {
            PG8_LDB(B0, 0, 0); PG8_SCHED; PG8_LDA(At, 0, 0); PG8_STAGE(PG8_SA(1, 1), a1 + hstep, voffA);
            PG8_WAIT_L(8); PG8_BAR; PG8_WAIT_L(0); PG8_MMA(0, 0, At, B0); PG8_BAR; PG8_SCHED;
            PG8_LDB(B1, 0, 1); PG8_STAGE(PG8_SB(0, 0), b2, voffB);
            PG8_BAR; PG8_WAIT_L(0); PG8_MMA(0, 1, At, B1); PG8_BAR;
            PG8_LDA(At, 0, 1); PG8_STAGE(PG8_SA(0, 0), a2, voffA);
            PG8_BAR; PG8_WAIT_L(0); PG8_MMA(1, 0, At, B0); PG8_BAR; PG8_SCHED;
            PG8_STAGE(PG8_SB(0, 1), b2 + hstep, voffB);
            PG8_WAIT_V(6); PG8_BAR; PG8_MMA(1, 1, At, B1); PG8_BAR;
            PG8_LDB(B0, 1, 0); PG8_SCHED; PG8_LDA(At, 1, 0); PG8_STAGE(PG8_SA(0, 1), a2 + hstep, voffA);
            PG8_WAIT_L(8); PG8_BAR; PG8_WAIT_L(0); PG8_MMA(0, 0, At, B0); PG8_BAR; PG8_SCHED;
            PG8_LDB(B1, 1, 1); PG8_STAGE(PG8_SB(1, 0), b3, voffB);
            PG8_BAR; PG8_WAIT_L(0); PG8_MMA(0, 1, At, B1); PG8_BAR;
            PG8_LDA(At, 1, 1); PG8_STAGE(PG8_SA(1, 0), a3, voffA);
            PG8_BAR; PG8_WAIT_L(0); PG8_MMA(1, 0, At, B0); PG8_BAR; PG8_SCHED;
            PG8_STAGE(PG8_SB(1, 1), b3 + hstep, voffB);
            PG8_WAIT_V(6); PG8_BAR; PG8_MMA(1, 1, At, B1); PG8_BAR;
            }
        }
        if constexpr (ALIGN_EPI) { if (wr == 0) PG8_BAR; }
        if constexpr (!Epi::AFTER_DRAIN) { E(acc, cur, wr, wc, fr, fq); S.done(cur); }
        if (!has_next) break;
#pragma unroll
        for (int a = 0; a < 2; ++a)
#pragma unroll
            for (int b = 0; b < 2; ++b)
#pragma unroll
                for (int m = 0; m < 4; ++m)
#pragma unroll
                    for (int n = 0; n < 2; ++n) acc[a][b][m][n] = (f32x4){0.f, 0.f, 0.f, 0.f};
        cur = nxt; cA = nA; cB = nB; ++ui;
        if constexpr (ALIGN_EPI) { if (wr == 1) PG8_BAR; }
    }
    PG8_WAIT_V(0);
    if constexpr (!ALIGN_EPI) { if (wr == 0) PG8_BAR; }
    PG8_BAR;
    if constexpr (Epi::AFTER_DRAIN) { E.fused(acc, cur, wr, wc, fr, fq, lds, wid, lane); S.done(cur); }
#undef PG8_SA
#undef PG8_SB
#undef PG8_STAGE
#undef PG8_LDA
#undef PG8_LDB
#undef PG8_MMA
#undef PG8_WAIT_V
#undef PG8_WAIT_L
#undef PG8_BAR
#undef PG8_SCHED
}
}
namespace attn {
using bf16x8 = __attribute__((ext_vector_type(8))) short;
using s16x4  = __attribute__((ext_vector_type(4))) short;
using f32x16 = __attribute__((ext_vector_type(16))) float;
using f32x4v = __attribute__((ext_vector_type(4))) float;
using u32x4  = __attribute__((ext_vector_type(4))) unsigned;
constexpr int LDP = 2048;
constexpr int KVBLK = 64, NT = SEQ / KVBLK;
constexpr int SHM_V = KVBLK * 128 * 2, SHM_K = KVBLK * 128 * 2;
constexpr int OFF_V = 0, OFF_K = 2 * SHM_V, OFF_WS = OFF_K + 2 * SHM_K, OFF_X = OFF_WS + 8 * 64 * 4, XROW = 132, X_BYTES = 4 * 32 * XROW * 4, ATTN_LDS = OFF_X + X_BYTES;
constexpr float C2 = 0.125f * 1.4426950408889634f;
constexpr float THR2 = 8.0f;
#define KSWZ(row, colB) ((row) * 256 + ((colB) ^ (((row) & 7) << 4)))
#define SBAR() __builtin_amdgcn_sched_barrier(0)
__device__ __forceinline__ int crow(int r, int hi) { return (r & 3) + 8 * (r >> 2) + 4 * hi; }
__device__ __forceinline__ unsigned cvtpk(float lo, float hi) { return pg8::cvt_pk_bf16(lo, hi); }
__device__ __forceinline__ int v_st(int k, int c) { const int kk = (k & ~0xC) | ((k & 4) << 1) | ((k & 8) >> 1); return ((kk >> 3) * 4 + (c >> 5)) * 512 + ((kk & 7) * 32 + (c & 31)) * 2; }
__device__ __forceinline__ int v_rd_base(int lane) { return ((lane & 3) << 3) | (((lane >> 2) & 3) << 6) | (((lane >> 4) & 1) << 5) | (((lane >> 5) & 1) << 8); }
constexpr int v_rd_off(int d0, int ks, int half) { return d0 * 512 + ks * 4096 + half * 2048; }
template <int OFF> __device__ __forceinline__ s16x4 tr_read(int vb) { s16x4 r; asm volatile("ds_read_b64_tr_b16 %0, %1 offset:%2" : "=&v"(r) : "v"(vb), "i"(OFF) : "memory"); return r; }
template <int D0> __device__ __forceinline__ void pv_one(f32x16& od, int vb, bf16x8 pa0, bf16x8 pa1, bf16x8 pa2, bf16x8 pa3) {
  const s16x4 l0 = tr_read<v_rd_off(D0, 0, 0)>(vb), h0 = tr_read<v_rd_off(D0, 0, 1)>(vb), l1 = tr_read<v_rd_off(D0, 1, 0)>(vb), h1 = tr_read<v_rd_off(D0, 1, 1)>(vb);
  const s16x4 l2 = tr_read<v_rd_off(D0, 2, 0)>(vb), h2 = tr_read<v_rd_off(D0, 2, 1)>(vb), l3 = tr_read<v_rd_off(D0, 3, 0)>(vb), h3 = tr_read<v_rd_off(D0, 3, 1)>(vb);
  asm volatile("s_waitcnt lgkmcnt(0)" ::: "memory"); SBAR();
#define PK(L, H) (bf16x8){L[0], L[1], L[2], L[3], H[0], H[1], H[2], H[3]}
  od = __builtin_amdgcn_mfma_f32_32x32x16_bf16(pa0, PK(l0, h0), od, 0, 0, 0);
  od = __builtin_amdgcn_mfma_f32_32x32x16_bf16(pa1, PK(l1, h1), od, 0, 0, 0);
  od = __builtin_amdgcn_mfma_f32_32x32x16_bf16(pa2, PK(l2, h2), od, 0, 0, 0);
  od = __builtin_amdgcn_mfma_f32_32x32x16_bf16(pa3, PK(l3, h3), od, 0, 0, 0);
#undef PK
}
__device__ __forceinline__ void pv_d0(f32x16* o, int vb, bf16x8 pa0, bf16x8 pa1, bf16x8 pa2, bf16x8 pa3) {
  pv_one<0>(o[0], vb, pa0, pa1, pa2, pa3); pv_one<1>(o[1], vb, pa0, pa1, pa2, pa3); pv_one<2>(o[2], vb, pa0, pa1, pa2, pa3); pv_one<3>(o[3], vb, pa0, pa1, pa2, pa3);
}
__device__ __forceinline__ void qkt(f32x16& p0, f32x16& p1, const char* Ks, const bf16x8* qr, int c, int r32, int hi) {
  p0 = f32x16{}; p1 = f32x16{};
#pragma unroll
  for (int d0 = 0; d0 < 4; ++d0) { const int cb = ((4 * c + d0) * 16 + hi * 8) * 2;
    const bf16x8 b0 = *reinterpret_cast<const bf16x8*>(Ks + KSWZ(r32, cb));
    const bf16x8 b1 = *reinterpret_cast<const bf16x8*>(Ks + KSWZ(32 + r32, cb));
    p0 = __builtin_amdgcn_mfma_f32_32x32x16_bf16(b0, qr[d0], p0, 0, 0, 0);
    p1 = __builtin_amdgcn_mfma_f32_32x32x16_bf16(b1, qr[d0], p1, 0, 0, 0); }
}
__device__ __forceinline__ void partialSM(f32x16& p0, f32x16& p1, float dq, float jb, float nsl2, float& m_reg, float& alpha) {
  const float db = dq - jb;
#pragma unroll
  for (int r = 0; r < 16; ++r) { const float d = db - (float)((r & 3) + 8 * (r >> 2)); p0[r] = fmaf(p0[r], C2, nsl2 * fabsf(d)); p1[r] = fmaf(p1[r], C2, nsl2 * fabsf(d - 32.f)); }
  float pmax = p0[0];
#pragma unroll
  for (int r = 1; r < 16; ++r) pmax = fmaxf(pmax, p0[r]);
#pragma unroll
  for (int r = 0; r < 16; ++r) pmax = fmaxf(pmax, p1[r]);
  { auto rr = __builtin_amdgcn_permlane32_swap(__float_as_uint(pmax), __float_as_uint(pmax), false, false); pmax = fmaxf(__uint_as_float(rr[0]), __uint_as_float(rr[1])); }
  float mn;
  if (__builtin_expect(__all(pmax - m_reg <= THR2), 1)) { mn = m_reg; alpha = 1.f; }
  else { mn = fmaxf(m_reg, pmax); alpha = __builtin_amdgcn_exp2f(m_reg - mn); m_reg = mn; }
#pragma unroll
  for (int r = 0; r < 16; ++r) { p0[r] = __builtin_amdgcn_exp2f(p0[r] - mn); p1[r] = p1[r] - mn; }
}
__device__ __forceinline__ void finishSM(f32x16& p0, f32x16& p1, float alpha, float& l_reg, bf16x8& pa0, bf16x8& pa1, bf16x8& pa2, bf16x8& pa3) {
#pragma unroll
  for (int r = 0; r < 16; ++r) p1[r] = __builtin_amdgcn_exp2f(p1[r]);
  float ps = 0;
#pragma unroll
  for (int r = 0; r < 16; ++r) ps += p0[r];
#pragma unroll
  for (int r = 0; r < 16; ++r) ps += p1[r];
  { auto rr = __builtin_amdgcn_permlane32_swap(__float_as_uint(ps), __float_as_uint(ps), false, false); ps = __uint_as_float(rr[0]) + __uint_as_float(rr[1]); }
  l_reg = l_reg * alpha + ps;
#define PK4(P, BASE, OUT) do { unsigned a0 = cvtpk(P[BASE + 0], P[BASE + 1]), a1 = cvtpk(P[BASE + 2], P[BASE + 3]);   \
    unsigned b0 = cvtpk(P[BASE + 4], P[BASE + 5]), b1 = cvtpk(P[BASE + 6], P[BASE + 7]);                              \
    auto r0 = __builtin_amdgcn_permlane32_swap(a0, b0, false, false); auto r1 = __builtin_amdgcn_permlane32_swap(a1, b1, false, false); \
    u32x4 w = {r0[0], r1[0], r0[1], r1[1]}; OUT = *reinterpret_cast<bf16x8*>(&w); } while (0)
  PK4(p0, 0, pa0); PK4(p0, 8, pa1); PK4(p1, 0, pa2); PK4(p1, 8, pa3);
#undef PK4
}
__device__ __forceinline__ int tile_at(int k, int tc) {
  if (k == 0) return tc;
  const int nL = tc, nR = NT - 1 - tc, m = nL < nR ? nL : nR;
  if (k <= 2 * m) return (k & 1) ? tc + ((k + 1) >> 1) : tc - (k >> 1);
  const int rest = k - 2 * m; return nR > nL ? tc + m + rest : tc - m - rest;
}
__device__ __forceinline__ void attn_unit(int b, int h, int qb, const bf16_t* __restrict__ proj, bf16_t* __restrict__ mix, float lam, const float* __restrict__ subg, char* lds) {
  const int tid = threadIdx.x, wid = tid >> 6, lane = tid & 63, r32 = lane & 31, hi = lane >> 5;
  const int c = wid & 1, qblk = wid >> 1;
  char* V_lds = lds + OFF_V; char* K_lds = lds + OFF_K;
  float* wsf = (float*)(lds + OFF_WS) + wid * 64; float* li_l = wsf; float* al_l = wsf + 32;
  const long rowbase = (long)b * SEQ; const int q0 = qb * 128 + qblk * 32;
  const bf16_t* Kh = proj + rowbase * LDP + 512 + h * 128; const bf16_t* Vh = proj + rowbase * LDP + 1024 + h * 128;
  float m_reg = -1e30f, l_reg = 0.f; f32x16 o[4] = {}; bf16x8 qr[4];
  { const bf16_t* Qw = proj + (rowbase + q0 + r32) * LDP + h * 128 + c * 64 + hi * 8;
#pragma unroll
    for (int d0 = 0; d0 < 4; ++d0) qr[d0] = *reinterpret_cast<const bf16x8*>(Qw + d0 * 16); }
  const float nsl2 = -exp2f(-2.0f * (float)(h + 1)) * 1.4426950408889634f;
  const float dl = (float)(q0 + r32 - 4 * hi);
  const int sr = tid >> 4, sc = (tid & 15) * 8, vst0 = v_st(sr, sc), vst1 = v_st(32 + sr, sc);
  const int vb0 = (int)(uintptr_t)V_lds + v_rd_base(lane);
  const int tc = (qb * 128) / KVBLK;
  struct { bf16x8 vs0, vs1, ks0, ks1; } sr_[2];
#define SLOAD(i, t) do { const long k0_ = (long)(t) * KVBLK; sr_[i].vs0 = *reinterpret_cast<const bf16x8*>(&Vh[(k0_ + sr) * LDP + sc]); sr_[i].vs1 = *reinterpret_cast<const bf16x8*>(&Vh[(k0_ + 32 + sr) * LDP + sc]); \
    sr_[i].ks0 = *reinterpret_cast<const bf16x8*>(&Kh[(k0_ + sr) * LDP + sc]); sr_[i].ks1 = *reinterpret_cast<const bf16x8*>(&Kh[(k0_ + 32 + sr) * LDP + sc]); } while (0)
#define SWRITE(bf, i) do { *(bf16x8*)(V_lds + (bf) * SHM_V + vst0) = sr_[i].vs0; *(bf16x8*)(V_lds + (bf) * SHM_V + vst1) = sr_[i].vs1; const int kc = sc * 2;   \
    *(bf16x8*)(K_lds + (bf) * SHM_K + KSWZ(sr, kc)) = sr_[i].ks0; *(bf16x8*)(K_lds + (bf) * SHM_K + KSWZ(32 + sr, kc)) = sr_[i].ks1; } while (0)
#define SWAIT() asm volatile("s_waitcnt vmcnt(4)" ::: "memory")
#define RESC(a) do { if (__any((a) < 1.f)) { if (hi == 0) al_l[r32] = (a); asm volatile("s_waitcnt lgkmcnt(0)" ::: "memory"); \
    _Pragma("unroll") for (int d = 0; d < 4; ++d) _Pragma("unroll") for (int r = 0; r < 16; ++r) o[d][r] *= al_l[crow(r, hi)]; } } while (0)
#define JB(k) ((float)(tile_at((k), tc) * KVBLK))
  f32x16 pA0, pA1, pB0, pB1; float alA, alB; bf16x8 pa0, pa1, pa2, pa3;
  constexpr int SE = 0, SO = 1;
  SLOAD(SE, tile_at(0, tc)); asm volatile("s_waitcnt vmcnt(0)" ::: "memory"); SWRITE(0, SE); __syncthreads();
  qkt(pA0, pA1, K_lds, qr, c, r32, hi); partialSM(pA0, pA1, dl, JB(0), nsl2, m_reg, alA);
  SLOAD(SO, tile_at(1, tc)); SLOAD(SE, tile_at(2, tc));
  SWAIT(); SWRITE(1, SO); __syncthreads();
  for (int j = 1; j + 1 < NT; j += 2) {
    SBAR(); qkt(pB0, pB1, K_lds + SHM_K, qr, c, r32, hi);
    finishSM(pA0, pA1, alA, l_reg, pa0, pa1, pa2, pa3); SBAR();
    SLOAD(SO, tile_at(j + 2, tc)); SBAR();
    pv_d0(o, vb0, pa0, pa1, pa2, pa3); partialSM(pB0, pB1, dl, JB(j), nsl2, m_reg, alB);
    __syncthreads(); SWAIT(); SWRITE(0, SE);
    RESC(alB); __syncthreads();
    SBAR(); qkt(pA0, pA1, K_lds, qr, c, r32, hi);
    finishSM(pB0, pB1, alB, l_reg, pa0, pa1, pa2, pa3); SBAR();
    if (j + 3 < NT) SLOAD(SE, tile_at(j + 3, tc)); SBAR();
    pv_d0(o, vb0 + SHM_V, pa0, pa1, pa2, pa3); partialSM(pA0, pA1, dl, JB(j + 1), nsl2, m_reg, alA);
    __syncthreads(); SWAIT(); SWRITE(1, SO);
    RESC(alA); __syncthreads();
  }
  SBAR(); qkt(pB0, pB1, K_lds + SHM_K, qr, c, r32, hi);
  finishSM(pA0, pA1, alA, l_reg, pa0, pa1, pa2, pa3); SBAR();
  pv_d0(o, vb0, pa0, pa1, pa2, pa3); partialSM(pB0, pB1, dl, JB(NT - 1), nsl2, m_reg, alB);
  __syncthreads(); RESC(alB);
  finishSM(pB0, pB1, alB, l_reg, pa0, pa1, pa2, pa3); SBAR();
  pv_d0(o, vb0 + SHM_V, pa0, pa1, pa2, pa3);
  if (hi == 0) li_l[r32] = l_reg; asm volatile("s_waitcnt lgkmcnt(0)" ::: "memory");
  float rli[16]; const float scl = c ? lam : 1.f;
#pragma unroll
  for (int r = 0; r < 16; ++r) rli[r] = __builtin_amdgcn_rcpf(li_l[crow(r, hi)]) * scl;
  float* X = (float*)(lds + OFF_X) + qblk * (32 * XROW);
  if (c == 1) {
#pragma unroll
    for (int r = 0; r < 16; ++r)
#pragma unroll
      for (int d0 = 0; d0 < 4; ++d0) X[crow(r, hi) * XROW + d0 * 32 + r32] = o[d0][r] * rli[r];
  }
  __syncthreads();
  if (c == 0) {
#pragma unroll
    for (int r = 0; r < 16; ++r)
#pragma unroll
      for (int d0 = 0; d0 < 4; ++d0) { float* xp = &X[crow(r, hi) * XROW + d0 * 32 + r32]; *xp = o[d0][r] * rli[r] - *xp; }
    asm volatile("s_waitcnt lgkmcnt(0)" ::: "memory");
    f32x4v v[16]; float ss = 0.f;
    const float* xr = X + r32 * XROW + hi * 64;
#pragma unroll
    for (int k = 0; k < 16; ++k) { v[k] = *(const f32x4v*)(xr + 4 * k); ss += (v[k][0] * v[k][0] + v[k][1] * v[k][1]) + (v[k][2] * v[k][2] + v[k][3] * v[k][3]); }
    { auto rr = __builtin_amdgcn_permlane32_swap(__float_as_uint(ss), __float_as_uint(ss), false, false); ss = __uint_as_float(rr[0]) + __uint_as_float(rr[1]); }
    const float rs = __builtin_amdgcn_rsqf(ss * (1.0f / 128.0f) + 1e-6f) * (1.0f - LAMBDA_INIT);
    bf16_t* orow = mix + (rowbase + q0 + r32) * 1024 + h * 128 + hi * 64; const float* gp = subg + hi * 64;
#pragma unroll
    for (int k = 0; k < 8; ++k) { const f32x4v a = v[2 * k] * rs * *(const f32x4v*)(gp + 8 * k), bq = v[2 * k + 1] * rs * *(const f32x4v*)(gp + 8 * k + 4);
      u32x4 w; w.x = cvtpk(a[0], a[1]); w.y = cvtpk(a[2], a[3]); w.z = cvtpk(bq[0], bq[1]); w.w = cvtpk(bq[2], bq[3]); *(u32x4*)(orow + 8 * k) = w; }
  }
  __syncthreads();
#undef SLOAD
#undef SWRITE
#undef SWAIT
#undef RESC
#undef JB
}
#undef KSWZ
#undef SBAR
}
#ifndef DBG_NOCARRY
#define DBG_NOCARRY 0
#endif
#ifndef DBG_SANITIZE
#define DBG_SANITIZE 0
#endif
namespace ssm {
using bf16x8 = __attribute__((ext_vector_type(8))) short;
using f32x16 = __attribute__((ext_vector_type(16))) float;
using f32x4v = __attribute__((ext_vector_type(4))) float;
using f32x2v = __attribute__((ext_vector_type(2))) float;
using u32x2v = __attribute__((ext_vector_type(2))) unsigned;
using u32x4v = __attribute__((ext_vector_type(4))) unsigned;
constexpr int LROW = 528;
constexpr int OFF_U = 0, OFF_SX = 128 * LROW, SSM_LDS = 2 * 128 * LROW;
constexpr int KC_G = 8192, WST_G = 65536, WCY_G = 65536;

struct Mode { float lr, li, dt; };
__device__ __forceinline__ Mode load_mode(const float* lam_re, const float* lam_im, const float* log_dt, int d, int g, int p) {
  Mode m; m.lr = lam_re[(d * NG + g) * NP + p]; m.li = lam_im[(d * NG + g) * NP + p]; m.dt = expf(log_dt[d * NG + g]); return m; }
__device__ __forceinline__ void apow(const Mode& m, float e, float& re, float& im) { const float mag = expf(e * m.lr * m.dt); float s, c; sincosf(e * m.li * m.dt, &s, &c); re = mag * c; im = mag * s; }
__device__ __forceinline__ void zoh(const Mode& m, float& cr, float& ci) {
  const float mag = expf(m.lr * m.dt), ang = m.li * m.dt; float s, c; sincosf(ang, &s, &c); const float sh = sinf(0.5f * ang);
  const float nr = expm1f(m.lr * m.dt) - 2.f * mag * sh * sh, ai = mag * s, den = m.lr * m.lr + m.li * m.li;
  cr = (nr * m.lr + ai * m.li) / den; ci = (ai * m.lr - nr * m.li) / den; }

struct Params { const float *lam_re, *lam_im, *log_dt, *b_re, *b_im, *c_re, *c_im, *dskip; };
constexpr int N_KC = NG * 31, N_WST = NG * 2 * 16, N_WCY = NG * 2 * 16, N_A16 = 2 * NG, N_ITEMS = N_KC + N_WST + N_WCY + N_A16;
__device__ __forceinline__ void table_item(int item, const Params& P, bf16_t* KC, bf16_t* WST, bf16_t* WCY, float* A16, float* scr, int lane) {
  const int p = lane;
  if (item < N_KC) {
    const int g = item / 31, dd = item % 31 - 15; const int e = dd < 0 ? -dd : dd;
    const int hp = lane >> 2, hq = (lane & 3) * 4; f32x4v acc = {0.f, 0.f, 0.f, 0.f};
    for (int d = 0; d < 2; ++d) {
      if ((dd > 0 && d == 1) || (dd < 0 && d == 0)) continue;
      const Mode m = load_mode(P.lam_re, P.lam_im, P.log_dt, d, g, p); float ar, ai, cr, ci; apow(m, (float)e, ar, ai); zoh(m, cr, ci);
      const float fr = ar * cr - ai * ci, fi = ar * ci + ai * cr;
      asm volatile("s_waitcnt lgkmcnt(0)" ::: "memory");
#pragma unroll
      for (int h = 0; h < 16; ++h) { const float br = P.b_re[(size_t)((d * NG + g) * NP + p) * GC + h], bi = P.b_im[(size_t)((d * NG + g) * NP + p) * GC + h];
        scr[p * 16 + h] = fr * br - fi * bi; scr[1024 + p * 16 + h] = fr * bi + fi * br; }
      asm volatile("s_waitcnt lgkmcnt(0)" ::: "memory");
      const float* cre = P.c_re + (size_t)((d * NG + g) * GC + hp) * NP; const float* cim = P.c_im + (size_t)((d * NG + g) * GC + hp) * NP;
      for (int q = 0; q < 64; ++q) { const float c0 = cre[q], c1 = cim[q]; const f32x4v er = *(const f32x4v*)(scr + q * 16 + hq), ei = *(const f32x4v*)(scr + 1024 + q * 16 + hq); acc += c0 * er - c1 * ei; }
    }
    if (dd == 0) {
#pragma unroll
      for (int i = 0; i < 4; ++i) if (hq + i == hp) acc[i] += P.dskip[g * GC + hp];
    }
    u32x2v w; w.x = pg8::cvt_pk_safe(acc[0], acc[1]); w.y = pg8::cvt_pk_safe(acc[2], acc[3]);
    *(u32x2v*)(KC + (size_t)g * KC_G + (dd + 15) * 256 + hp * 16 + hq) = w;
    return;
  }
  item -= N_KC;
  if (item < N_WST) {
    const int g = item >> 5, d = (item >> 4) & 1, j = item & 15; const float e = d == 0 ? (float)(15 - j) : (float)j;
    const Mode m = load_mode(P.lam_re, P.lam_im, P.log_dt, d, g, p); float ar, ai, cr, ci; apow(m, e, ar, ai); zoh(m, cr, ci);
    const float fr = ar * cr - ai * ci, fi = ar * ci + ai * cr; float vr[16], vi[16];
#pragma unroll
    for (int h = 0; h < 16; ++h) { const float br = P.b_re[(size_t)((d * NG + g) * NP + p) * GC + h], bi = P.b_im[(size_t)((d * NG + g) * NP + p) * GC + h]; vr[h] = fr * br - fi * bi; vi[h] = fr * bi + fi * br; }
    bf16_t* o_re = WST + (size_t)g * WST_G + (size_t)((d * 2 + 0) * 64 + p) * 256 + j * 16; bf16_t* o_im = WST + (size_t)g * WST_G + (size_t)((d * 2 + 1) * 64 + p) * 256 + j * 16;
#pragma unroll
    for (int k = 0; k < 2; ++k) { u32x4v w, x;
      w.x = pg8::cvt_pk_safe(vr[8 * k + 0], vr[8 * k + 1]); w.y = pg8::cvt_pk_safe(vr[8 * k + 2], vr[8 * k + 3]); w.z = pg8::cvt_pk_safe(vr[8 * k + 4], vr[8 * k + 5]); w.w = pg8::cvt_pk_safe(vr[8 * k + 6], vr[8 * k + 7]);
      x.x = pg8::cvt_pk_safe(vi[8 * k + 0], vi[8 * k + 1]); x.y = pg8::cvt_pk_safe(vi[8 * k + 2], vi[8 * k + 3]); x.z = pg8::cvt_pk_safe(vi[8 * k + 4], vi[8 * k + 5]); x.w = pg8::cvt_pk_safe(vi[8 * k + 6], vi[8 * k + 7]);
      *(u32x4v*)(o_re + 8 * k) = w; *(u32x4v*)(o_im + 8 * k) = x; }
    return;
  }
  item -= N_WST;
  if (item < N_WCY) {
    const int g = item >> 5, d = (item >> 4) & 1, i = item & 15; const float e = d == 0 ? (float)(i + 1) : (float)(16 - i);
    const Mode m = load_mode(P.lam_re, P.lam_im, P.log_dt, d, g, p); float ar, ai; apow(m, e, ar, ai);
    for (int hp = 0; hp < 16; ++hp) { const float c0 = P.c_re[(size_t)((d * NG + g) * GC + hp) * NP + p], c1 = P.c_im[(size_t)((d * NG + g) * GC + hp) * NP + p];
      bf16_t* o = WCY + (size_t)g * WCY_G + (size_t)(i * 16 + hp) * 256 + d * 128 + p;
      o[0] = f2bf(c0 * ar - c1 * ai); o[64] = f2bf(-(c0 * ai + c1 * ar)); }
    return;
  }
  item -= N_WCY;
  { const int d = item / NG, g = item % NG; const Mode m = load_mode(P.lam_re, P.lam_im, P.log_dt, d, g, p); float ar, ai; apow(m, 16.f, ar, ai);
    *(f32x2v*)(A16 + (size_t)((d * NG + g) * NP + p) * 2) = (f32x2v){ar, ai}; }
}

#ifndef DBG_DUMP
#define DBG_DUMP 0
#endif
__device__ __forceinline__ void ssm_unit(int b, int g, const bf16_t* __restrict__ proj, bf16_t* __restrict__ Z, const bf16_t* __restrict__ KC, const bf16_t* __restrict__ WST, const bf16_t* __restrict__ WCY,
                                         const float* __restrict__ A16, char* lds, bf16_t* DBG_D1 = nullptr, bf16_t* DBG_D2 = nullptr) {
  const int tid = threadIdx.x, wid = tid >> 6, lane = tid & 63, r32 = lane & 31, hi = lane >> 5;
  char* U = lds + OFF_U; char* SX = lds + OFF_SX;
  { const bf16_t* up = proj + (size_t)b * SEQ * 2048 + 1536 + g * GC;
    u32x4v t[8];
#pragma unroll
    for (int k = 0; k < 8; ++k) { const int idx = tid + 512 * k, tok = idx >> 1, half = idx & 1; t[k] = *(const u32x4v*)(up + (size_t)tok * 2048 + half * 8); }
#pragma unroll
    for (int k = 0; k < 8; ++k) { const int idx = tid + 512 * k, tok = idx >> 1, half = idx & 1; *(u32x4v*)(U + (tok >> 4) * LROW + (tok & 15) * 32 + half * 16) = t[k]; } }
  __syncthreads();
  {
    f32x16 acc[4] = {};
    const bf16_t* wrow = WST + (size_t)g * WST_G + (size_t)(32 * wid + r32) * 256 + 8 * hi;
#pragma unroll
    for (int jh = 0; jh < 2; ++jh) {
      bf16x8 af[8];
#pragma unroll
      for (int j = 0; j < 8; ++j) af[j] = *reinterpret_cast<const bf16x8*>(wrow + 16 * (8 * jh + j));
#pragma unroll
      for (int j = 0; j < 8; ++j)
#pragma unroll
        for (int cb = 0; cb < 4; ++cb) { const bf16x8 bf = *reinterpret_cast<const bf16x8*>(U + (32 * cb + r32) * LROW + (16 * (8 * jh + j) + 8 * hi) * 2);
          acc[cb] = __builtin_amdgcn_mfma_f32_32x32x16_bf16(af[j], bf, acc[cb], 0, 0, 0); }
    }
#pragma unroll
    for (int cb = 0; cb < 4; ++cb)
#pragma unroll
      for (int q = 0; q < 4; ++q) { u32x2v w; w.x = pg8::cvt_pk_safe(acc[cb][4 * q], acc[cb][4 * q + 1]); w.y = pg8::cvt_pk_safe(acc[cb][4 * q + 2], acc[cb][4 * q + 3]);
        *(u32x2v*)(SX + (32 * cb + r32) * LROW + (32 * wid + 8 * q + 4 * hi) * 2) = w; }
  }
  __syncthreads();
#if DBG_DUMP
  { bf16_t* D1 = DBG_D1 + ((size_t)(b * NG + g) * 128) * 256; for (int i_ = tid; i_ < 128 * 256; i_ += 512) D1[i_] = ((const bf16_t*)SX)[(i_ >> 8) * (LROW / 2) + (i_ & 255)]; }
  __syncthreads();
#endif
  if (wid < 2) {
    const int d = wid; const f32x2v a16 = *(const f32x2v*)(A16 + (size_t)((d * NG + g) * NP + lane) * 2);
    float xr = 0.f, xi = 0.f;
    bf16_t* col = (bf16_t*)SX + d * 128 + lane;
    for (int c8 = 0; c8 < 128; c8 += 8) {
      float sr[8], si[8];
#pragma unroll
      for (int k = 0; k < 8; ++k) { const int c = d == 0 ? c8 + k : 127 - (c8 + k); sr[k] = bf2f(col[c * (LROW / 2)]); si[k] = bf2f(col[c * (LROW / 2) + 64]); }
#pragma unroll
      for (int k = 0; k < 8; ++k) { const int c = d == 0 ? c8 + k : 127 - (c8 + k); col[c * (LROW / 2)] = f2bf(xr); col[c * (LROW / 2) + 64] = f2bf(xi);
        const float nr = a16.x * xr - a16.y * xi + sr[k], ni = a16.x * xi + a16.y * xr + si[k]; xr = nr; xi = ni; }
    }
  }
  __syncthreads();
#if DBG_DUMP
  { bf16_t* D2 = DBG_D2 + ((size_t)(b * NG + g) * 128) * 256; for (int i_ = tid; i_ < 128 * 256; i_ += 512) D2[i_] = ((const bf16_t*)SX)[(i_ >> 8) * (LROW / 2) + (i_ & 255)]; }
  __syncthreads();
#endif
  {
    f32x16 acc[4] = {};
    const int il = 2 * wid + (r32 >> 4), hp = r32 & 15;
    const bf16_t* kc = KC + (size_t)g * KC_G + (il + 15) * 256 + hp * 16 + 8 * hi;
#pragma unroll
    for (int jh = 0; jh < 2; ++jh) {
      bf16x8 af[8];
#pragma unroll
      for (int j = 0; j < 8; ++j) af[j] = *reinterpret_cast<const bf16x8*>(kc - 256 * (8 * jh + j));
#pragma unroll
      for (int j = 0; j < 8; ++j)
#pragma unroll
        for (int cb = 0; cb < 4; ++cb) { const bf16x8 bf = *reinterpret_cast<const bf16x8*>(U + (32 * cb + r32) * LROW + (16 * (8 * jh + j) + 8 * hi) * 2);
          acc[cb] = __builtin_amdgcn_mfma_f32_32x32x16_bf16(af[j], bf, acc[cb], 0, 0, 0); }
    }
#if !DBG_NOCARRY
    const bf16_t* wrow = WCY + (size_t)g * WCY_G + (size_t)(32 * wid + r32) * 256 + 8 * hi;
#pragma unroll
    for (int sh = 0; sh < 2; ++sh) {
      bf16x8 af[8];
#pragma unroll
      for (int s = 0; s < 8; ++s) af[s] = *reinterpret_cast<const bf16x8*>(wrow + 16 * (8 * sh + s));
#pragma unroll
      for (int s = 0; s < 8; ++s)
#pragma unroll
        for (int cb = 0; cb < 4; ++cb) { const bf16x8 bf = *reinterpret_cast<const bf16x8*>(SX + (32 * cb + r32) * LROW + (16 * (8 * sh + s) + 8 * hi) * 2);
          acc[cb] = __builtin_amdgcn_mfma_f32_32x32x16_bf16(af[s], bf, acc[cb], 0, 0, 0); }
    }
#endif
#pragma unroll
    for (int cb = 0; cb < 4; ++cb)
#pragma unroll
      for (int q = 0; q < 4; ++q) { const int tok = 16 * (32 * cb + r32) + 2 * wid + (q >> 1), h0 = 4 * hi + 8 * (q & 1);
#if DBG_SANITIZE
        for (int i_ = 0; i_ < 4; ++i_) if (!(fabsf(acc[cb][4 * q + i_]) < 1e4f)) acc[cb][4 * q + i_] = 0.f;
#endif
        const pg8::f32x2 z0 = pg8::gelu_pk((pg8::f32x2){acc[cb][4 * q], acc[cb][4 * q + 1]}), z1 = pg8::gelu_pk((pg8::f32x2){acc[cb][4 * q + 2], acc[cb][4 * q + 3]});
        u32x2v w; w.x = pg8::cvt_pk_safe(z0.x, z0.y); w.y = pg8::cvt_pk_safe(z1.x, z1.y);
        *(u32x2v*)(Z + ((size_t)b * SEQ + tok) * SSMW + g * GC + h0) = w; }
  }
  __syncthreads();
}
}
#define GAS __attribute__((address_space(1)))
#define LAS __attribute__((address_space(3)))
typedef unsigned v4u __attribute__((ext_vector_type(4)));
typedef float f32x4 __attribute__((ext_vector_type(4)));
typedef GAS unsigned gu32;
#define RLX_AGENT __ATOMIC_RELAXED, __HIP_MEMORY_SCOPE_AGENT
#define LDS_WAIT() asm volatile("s_waitcnt lgkmcnt(0)" ::: "memory")
#define VM_WAIT() asm volatile("s_waitcnt vmcnt(0)" ::: "memory")
constexpr int NWAVES = 8;
constexpr int RING_OFF = 0, RING_BYTES = 139264, LDSCTL_OFF = RING_BYTES, MISC_OFF = LDSCTL_OFF + 320, LDS_BYTES = 147456;
constexpr size_t WS_CTL = 0, CTL_ZERO_BYTES = 1 * MiB;
constexpr int CW_BAR = 4096;
#define XB_TMO      128
#define XB_XCNT(j)  (256  + 64 * (j))
#define XB_XSUB(j)  (1280 + 64 * (j))
#define XB_XGEN(j)  (2304 + 64 * (j))
#define XB_TOP      3328
#define XB_TOPGEN   3392
#define XCD_BAR_WORDS 3456
#define XB_SPIN_CAP (1u << 18)

__device__ __forceinline__ unsigned xb_ld(unsigned* p)              { return __hip_atomic_load(p, __ATOMIC_RELAXED, __HIP_MEMORY_SCOPE_AGENT); }
__device__ __forceinline__ unsigned xb_add(unsigned* p, unsigned v) { return __hip_atomic_fetch_add(p, v, __ATOMIC_RELAXED, __HIP_MEMORY_SCOPE_AGENT); }
__device__ __forceinline__ unsigned xb_xcc_id() { return (unsigned)__builtin_amdgcn_s_getreg((3 << 11) | 20) & 0xFu; }
#define XB_SPIN(cond, bar) do { unsigned _sp = 0; while (cond) { __builtin_amdgcn_s_sleep(1); \
    if ((++_sp & 255u) == 0u) { if (xb_ld(&(bar)[XB_TMO])) break; if (_sp > XB_SPIN_CAP) { atomicAdd(&(bar)[XB_TMO], 1u); break; } } } } while (0)

struct XcdBarrier {
    unsigned* bar; unsigned x;
    volatile LAS unsigned* st;
};

__device__ __forceinline__ XcdBarrier xcd_barrier_post(unsigned* bar, volatile LAS unsigned* st) {
    XcdBarrier b; b.bar = bar; b.x = xb_xcc_id(); b.st = st;
    if (threadIdx.x == 0) (void)xb_add(&bar[XB_XCNT(b.x)], 1u);
    return b;
}
__device__ __forceinline__ void xcd_barrier_complete(unsigned* bar, unsigned x, unsigned& nloc, unsigned& nx) {
    const unsigned G = gridDim.x * gridDim.y * gridDim.z;
    unsigned sum, cnt, mine, sp = 0u;
    for (;;) {
        sum = 0u; cnt = 0u; mine = 0u;
#pragma unroll
        for (unsigned j = 0; j < 16; ++j) { const unsigned c = xb_ld(&bar[XB_XCNT(j)]); sum += c; cnt += (c > 0u) ? 1u : 0u; mine = (j == x) ? c : mine; }
        if (sum == G) break;
        __builtin_amdgcn_s_sleep(1);
        if ((++sp & 255u) == 0u) { if (xb_ld(&bar[XB_TMO])) break; if (sp > XB_SPIN_CAP) { atomicAdd(&bar[XB_TMO], 1u); break; } }
    }
    nloc = mine > 0u ? mine : 1u; nx = cnt > 0u ? cnt : 1u;
}

__device__ __forceinline__ void xcd_barrier(const XcdBarrier& b) {
    asm volatile("s_waitcnt vmcnt(0)" ::: "memory");
    __syncthreads();
    if (threadIdx.x == 0) {
        unsigned* bar = b.bar;
        __builtin_amdgcn_s_waitcnt(0);
        unsigned nloc = b.st[0], nx = b.st[1];
        if (nloc == 0u) { xcd_barrier_complete(bar, b.x, nloc, nx); b.st[0] = nloc; b.st[1] = nx; }
        const unsigned old = xb_add(&bar[XB_XSUB(b.x)], 1u);
        const unsigned gen = old / nloc;
        if (old + 1u == (gen + 1u) * nloc) {
            __builtin_amdgcn_fence(__ATOMIC_RELEASE, "agent");
            asm volatile("s_waitcnt vmcnt(0)" ::: "memory");
            const unsigned og = xb_add(&bar[XB_TOP], 1u);
            const unsigned tg = og / nx;
            if (og + 1u == (tg + 1u) * nx) xb_add(&bar[XB_TOPGEN], 1u);
            else XB_SPIN(xb_ld(&bar[XB_TOPGEN]) == tg, bar);
            __builtin_amdgcn_fence(__ATOMIC_ACQUIRE, "agent");
            xb_add(&bar[XB_XGEN(b.x)], 1u);
            asm volatile("s_waitcnt vmcnt(0)" ::: "memory");
        } else {
            XB_SPIN(xb_ld(&bar[XB_XGEN(b.x)]) == gen, bar);
            __builtin_amdgcn_fence(__ATOMIC_ACQUIRE, "agent");
            asm volatile("s_waitcnt vmcnt(0)" ::: "memory");
        }
    }
    __syncthreads();
}

__device__ __forceinline__ void p0_transpose_item(const float* W, const float* scale, int K, int N, bf16_t* WT, LAS float* scr, int item, int lane) {
    const int nblk = N / 32, kb = item / nblk, nb = item % nblk, k0 = 64 * kb, n0 = 32 * nb;
#pragma unroll 8
    for (int i = 0; i < 32; ++i) { const int kk = 2 * i + (lane >> 5); float w = W[(size_t)(k0 + kk) * N + n0 + (lane & 31)]; if (scale) w *= scale[k0 + kk]; scr[kk * 33 + (lane & 31)] = w; }
    LDS_WAIT(); asm volatile("" ::: "memory");
    const int c = lane & 7;
#pragma unroll
    for (int j = 0; j < 4; ++j) { const int n = (lane >> 3) + 8 * j; const LAS float* s = scr + (8 * c) * 33 + n;
        v4u o; o.x = pg8::cvt_pk_bf16(s[0 * 33], s[1 * 33]); o.y = pg8::cvt_pk_bf16(s[2 * 33], s[3 * 33]); o.z = pg8::cvt_pk_bf16(s[4 * 33], s[5 * 33]); o.w = pg8::cvt_pk_bf16(s[6 * 33], s[7 * 33]);
        *(GAS v4u*)(WT + (size_t)(n0 + n) * K + k0 + 8 * c) = o; }
    LDS_WAIT(); asm volatile("" ::: "memory");
}
__device__ __forceinline__ void rms_row_to_bf16(const float* xrow, const float* g, bf16_t* orow, int lane) {
    const GAS f32x4* xr = (const GAS f32x4*)xrow + lane; const GAS f32x4* gr = (const GAS f32x4*)g + lane;
    f32x4 v[4]; float s = 0.f;
#pragma unroll
    for (int j = 0; j < 4; ++j) { v[j] = xr[64 * j]; s += (v[j].x * v[j].x + v[j].y * v[j].y) + (v[j].z * v[j].z + v[j].w * v[j].w); }
    const float r = __builtin_amdgcn_rsqf(wave_sum(s) * (1.f / DM) + EPS);
    GAS unsigned long long* o8 = (GAS unsigned long long*)orow + lane;
#pragma unroll
    for (int j = 0; j < 4; ++j) { const f32x4 gg = gr[64 * j]; o8[64 * j] = (unsigned long long)pg8::cvt_pk_bf16(v[j].x * r * gg.x, v[j].y * r * gg.y) | ((unsigned long long)pg8::cvt_pk_bf16(v[j].z * r * gg.z, v[j].w * r * gg.w) << 32); }
}
struct Args { const float* in[23]; float* out; unsigned char* ws; int ph_lo, ph_hi, ssm_in, pad; };
__global__ void __launch_bounds__(NWAVES * 64, 2) mk_fwd(Args args) {
    extern __shared__ __attribute__((aligned(16))) unsigned char lds[];
    LAS unsigned char* L = (LAS unsigned char*)lds;
    volatile LAS unsigned* MISC = (volatile LAS unsigned*)(L + MISC_OFF);
    const int tid = threadIdx.x, lane = tid & 63, wave = __builtin_amdgcn_readfirstlane(tid >> 6);
    const int G = gridDim.x, bx = blockIdx.x;
    const int vcu = (G % 8 == 0) ? (bx % 8) * (G / 8) + bx / 8 : bx;
    unsigned char* ws = args.ws;
    gu32* ctl = (gu32*)(ws + WS_CTL);
    const float* x = args.in[0]; float* out = args.out;
    bf16_t* WIN = (bf16_t*)(ws + WS_WIN); bf16_t* WGLU = (bf16_t*)(ws + WS_WGLU); bf16_t* WOUT = (bf16_t*)(ws + WS_WOUT); bf16_t* W1T = (bf16_t*)(ws + WS_W1); bf16_t* W2T = (bf16_t*)(ws + WS_W2);
    bf16_t* KC = (bf16_t*)(ws + WS_KC); bf16_t* WST = (bf16_t*)(ws + WS_WST); bf16_t* WCY = (bf16_t*)(ws + WS_WCY); float* A16 = (float*)(ws + WS_A16);
    float* SS1 = (float*)(ws + WS_SS1); float* SS2 = (float*)(ws + WS_SS2);
    bf16_t* XN = (bf16_t*)(ws + WS_XN); bf16_t* PROJ = (bf16_t*)(ws + WS_PROJ); bf16_t* MIX = (bf16_t*)(ws + WS_MIX); bf16_t* Z = (bf16_t*)(ws + WS_Z); bf16_t* H = (bf16_t*)(ws + WS_H);
    for (int u = tid; u < (LDS_BYTES - LDSCTL_OFF) / 4; u += NWAVES * 64) ((LAS unsigned*)(L + LDSCTL_OFF))[u] = 0u;
    __syncthreads();
    const int lo = args.ph_lo, hi = args.ph_hi;
    XcdBarrier bar; bar.bar = (unsigned*)(ctl + CW_BAR); bar.x = 0; bar.st = nullptr;
    if (hi - lo > 1) bar = xcd_barrier_post((unsigned*)(ctl + CW_BAR), MISC + 8);
#define IN(k) (lo <= (k) && (k) < hi)
#define BOTH(k) (IN(k) && IN((k) + 1))
#define GRID_BAR() xcd_barrier(bar)


    if (IN(0)) {
        LAS float* scr = (LAS float*)(L + RING_OFF + wave * 16384);
        const int gw = vcu * NWAVES + wave, NGW = G * NWAVES;
        constexpr int I_IN = (DM / 64) * (NPROJ / 32), I_GLU = (SSMW / 64) * (SSMW / 32), I_OUT = (DM / 64) * (DM / 32), I_1 = (DM / 64) * (FF / 32), I_2 = (FF / 64) * (DM / 32);
        constexpr int NITEMS = I_IN + I_GLU + I_OUT + I_1 + I_2;
        for (int it = gw; it < NITEMS; it += NGW) {
            int r = it;
            if (r < I_IN) { p0_transpose_item(args.in[2], nullptr, DM, NPROJ, WIN, scr, r, lane); continue; } r -= I_IN;
            if (r < I_GLU) { p0_transpose_item(args.in[16], nullptr, SSMW, SSMW, WGLU, scr, r, lane); continue; } r -= I_GLU;
            if (r < I_OUT) { p0_transpose_item(args.in[18], nullptr, DM, DM, WOUT, scr, r, lane); continue; } r -= I_OUT;
            if (r < I_1) { p0_transpose_item(args.in[20], args.in[19], DM, FF, W1T, scr, r, lane); continue; } r -= I_1;
            p0_transpose_item(args.in[21], nullptr, FF, DM, W2T, scr, r, lane);
        }
        { ssm::Params SP{args.in[8], args.in[9], args.in[10], args.in[11], args.in[12], args.in[13], args.in[14], args.in[15]};
          for (int it = gw; it < ssm::N_ITEMS; it += NGW) ssm::table_item(it, SP, KC, WST, WCY, A16, (float*)((char*)lds + RING_OFF + wave * 16384), lane); }
        for (int m = gw; m < M_TOK; m += NGW) rms_row_to_bf16(x + (size_t)m * DM, args.in[1], XN + (size_t)m * DM, lane);
        if (BOTH(0)) GRID_BAR();
    }
    if (IN(1)) {
        pg8::Gemm g{XN, WIN, M_TOK, NPROJ, DM}; pg8::StaticOrder S; S.init(M_TOK, NPROJ, G, bx);
        pg8::EpiProj E{PROJ, NPROJ};
        pg8::gemm_phase<pg8::EpiProj, pg8::StaticOrder, true, true>(L + RING_OFF, g, S, E);
        if (BOTH(1)) GRID_BAR();
    }

    if (IN(2)) {
        const float lam = expf(wave_sum(args.in[3][lane] * args.in[4][lane])) - expf(wave_sum(args.in[5][lane] * args.in[6][lane])) + LAMBDA_INIT;
        const int bh = vcu >> 3;
        for (int i = 0; i < 2; ++i) attn::attn_unit(bh >> 2, bh & 3, (vcu & 7) * 2 + i, PROJ, MIX, lam, args.in[7], (char*)lds + RING_OFF);
        if (args.ssm_in) ssm::ssm_unit(vcu & 7, vcu >> 3, PROJ, Z, KC, WST, WCY, A16, (char*)lds + RING_OFF, (bf16_t*)(ws + 200 * MiB), (bf16_t*)(ws + 216 * MiB));
        if (BOTH(2)) GRID_BAR();
    }
    if (IN(3)) {
        pg8::Gemm g{Z, WGLU, M_TOK, SSMW, SSMW}; pg8::StaticOrder S; S.init(M_TOK, SSMW, G, bx);
        pg8::EpiGlu E{Z, args.in[17], MIX};
        pg8::gemm_phase<pg8::EpiGlu, pg8::StaticOrder, true, true>(L + RING_OFF, g, S, E);
        if (BOTH(3)) GRID_BAR();
    }
    if (IN(4)) {
        pg8::Gemm g{MIX, WOUT, M_TOK, DM, DM}; pg8::StaticOrder S; S.init(M_TOK, DM, G, bx);
        pg8::EpiResid<true> E{x, out, XN, SS1};
        pg8::gemm_phase<pg8::EpiResid<true>, pg8::StaticOrder, true, true>(L + RING_OFF, g, S, E);
        if (BOTH(4)) GRID_BAR();
    }
    if (IN(5)) {
        pg8::Gemm g{XN, W1T, M_TOK, FF, DM}; pg8::StaticOrder S; S.init(M_TOK, FF, G, bx);
        pg8::EpiUp E{H, FF, SS1};
        pg8::gemm_phase<pg8::EpiUp, pg8::StaticOrder, true, true>(L + RING_OFF, g, S, E);
        if (BOTH(5)) GRID_BAR();
    }
    if (IN(6)) {
        pg8::Gemm g{H, W2T, M_TOK, DM, FF}; pg8::StaticOrder S; S.init(M_TOK, DM, G, bx);
        pg8::EpiResid<false> E{out, out, nullptr, SS2};
        pg8::gemm_phase<pg8::EpiResid<false>, pg8::StaticOrder, true, true>(L + RING_OFF, g, S, E);
        if (BOTH(6)) GRID_BAR();
    }
    if (IN(7)) {
        const float* gf = args.in[22];
        const int gw = vcu * NWAVES + wave, NGW = G * NWAVES;
        for (int m = gw; m < M_TOK; m += NGW) {
            const float r = pg8::rstd16(SS2, m);
            GAS f32x4* o = (GAS f32x4*)(out + (size_t)m * DM) + lane; const GAS f32x4* gp = (const GAS f32x4*)gf + lane;
#pragma unroll
            for (int j = 0; j < 4; ++j) { f32x4 v = o[64 * j]; const f32x4 gg = gp[64 * j]; v = v * r * gg; o[64 * j] = v; }
        }
    }
#undef IN
#undef BOTH
#undef GRID_BAR
}
#ifndef DBG_CHUNKLOCAL
#define DBG_CHUNKLOCAL 0
#endif
__global__ void __launch_bounds__(256) k_transpose_w(const float* __restrict__ W, const float* __restrict__ scale, bf16_t* __restrict__ WT, int K, int N) {
    __shared__ float t[32][33];
    const int k0 = blockIdx.y * 32, n0 = blockIdx.x * 32, tx = threadIdx.x & 31, ty = threadIdx.x >> 5;
    for (int i = ty; i < 32; i += 8) { float s = scale ? scale[k0 + i] : 1.f; t[i][tx] = W[(size_t)(k0 + i) * N + n0 + tx] * s; }
    __syncthreads();
    for (int i = ty; i < 32; i += 8) WT[(size_t)(n0 + i) * K + k0 + tx] = f2bf(t[tx][i]);
}

__global__ void __launch_bounds__(256) k_rmsnorm_bf16(const float* __restrict__ x, const float* __restrict__ g, bf16_t* __restrict__ out) {
    const int row = blockIdx.x * 4 + (threadIdx.x >> 6), lane = threadIdx.x & 63;
    const float* xr = x + (size_t)row * DM; float v[16]; float s = 0.f;
#pragma unroll
    for (int j = 0; j < 16; ++j) { v[j] = xr[lane + 64 * j]; s += v[j] * v[j]; }
    const float r = rsqrtf(wave_sum(s) * (1.f / DM) + EPS);
#pragma unroll
    for (int j = 0; j < 16; ++j) out[(size_t)row * DM + lane + 64 * j] = f2bf(v[j] * r * g[lane + 64 * j]);
}

__global__ void __launch_bounds__(256) k_rowss(const float* __restrict__ h, float* __restrict__ ss) {
    const int row = blockIdx.x * 4 + (threadIdx.x >> 6), lane = threadIdx.x & 63;
    const float* xr = h + (size_t)row * DM; float s = 0.f;
#pragma unroll
    for (int j = 0; j < 16; ++j) { float v = xr[lane + 64 * j]; s += v * v; }
    s = wave_sum(s);
    if (lane < 16) ss[(size_t)row * 16 + lane] = lane == 0 ? s : 0.f;
}
__device__ __forceinline__ float row_rstd(const float* ss, int row) {
    float s = 0.f;
#pragma unroll
    for (int i = 0; i < 16; ++i) s += ss[(size_t)row * 16 + i];
    return rsqrtf(s * (1.f / DM) + EPS);
}
__global__ void __launch_bounds__(256) k_final(float* __restrict__ out, const float* __restrict__ ss, const float* __restrict__ g) {
    const int row = blockIdx.x * 4 + (threadIdx.x >> 6), lane = threadIdx.x & 63;
    const float r = row_rstd(ss, row);
    float* xr = out + (size_t)row * DM;
#pragma unroll
    for (int j = 0; j < 16; ++j) xr[lane + 64 * j] = xr[lane + 64 * j] * r * g[lane + 64 * j];
}

enum { EPI_PROJ = 0, EPI_GLU = 1, EPI_OUT = 2, EPI_UP = 3, EPI_DOWN = 4 };
struct EpiArgs { bf16_t* obf; float* of32; const float* x; const float* vec; const bf16_t* zin; const float* ss; int ldo; };
template <int EPI> __device__ __forceinline__ void epi_elem(const EpiArgs& e, int row, int col, float acc) {
    if (EPI == EPI_PROJ) e.obf[(size_t)row * e.ldo + col] = f2bf(acc);
    else if (EPI == EPI_GLU) { const float z = bf2f(e.zin[(size_t)row * SSMW + col]); const float s = 1.f / (1.f + __expf(-(acc + e.vec[col]))); e.obf[(size_t)row * e.ldo + SSMW + col] = f2bf(z * s); }
    else if (EPI == EPI_OUT) { const float h = e.x[(size_t)row * DM + col] + acc; e.of32[(size_t)row * DM + col] = h; e.obf[(size_t)row * DM + col] = f2bf(h); }
    else if (EPI == EPI_UP) { float v = acc * row_rstd(e.ss, row); v = fmaxf(v, 0.f); e.obf[(size_t)row * e.ldo + col] = f2bf(v * v); }
    else if (EPI == EPI_DOWN) { e.of32[(size_t)row * DM + col] += acc; }
}
template <int EPI> __global__ void __launch_bounds__(256) k_gemm_naive(const bf16_t* __restrict__ A, const bf16_t* __restrict__ Bt, int K, EpiArgs e) {
    __shared__ float As[64][33], Bs[64][33];
    const int tid = threadIdx.x, tx = tid & 15, ty = tid >> 4, m0 = blockIdx.y * 64, n0 = blockIdx.x * 64;
    float acc[4][4] = {};
    for (int k0 = 0; k0 < K; k0 += 32) {
        for (int i = tid; i < 64 * 32; i += 256) { const int r = i >> 5, c = i & 31; As[r][c] = bf2f(A[(size_t)(m0 + r) * K + k0 + c]); Bs[r][c] = bf2f(Bt[(size_t)(n0 + r) * K + k0 + c]); }
        __syncthreads();
#pragma unroll 8
        for (int k = 0; k < 32; ++k) { float a[4], b[4];
#pragma unroll
            for (int i = 0; i < 4; ++i) { a[i] = As[ty * 4 + i][k]; b[i] = Bs[tx * 4 + i][k]; }
#pragma unroll
            for (int i = 0; i < 4; ++i)
#pragma unroll
                for (int j = 0; j < 4; ++j) acc[i][j] = fmaf(a[i], b[j], acc[i][j]); }
        __syncthreads();
    }
#pragma unroll
    for (int i = 0; i < 4; ++i)
#pragma unroll
        for (int j = 0; j < 4; ++j) epi_elem<EPI>(e, m0 + ty * 4 + i, n0 + tx * 4 + j, acc[i][j]);
}

__global__ void __launch_bounds__(256) k_attn_naive(const bf16_t* __restrict__ proj, bf16_t* __restrict__ mix, const float* __restrict__ lq1, const float* __restrict__ lk1,
                                                    const float* __restrict__ lq2, const float* __restrict__ lk2, const float* __restrict__ subg) {
    __shared__ float abuf[4][SEQ];
    const int w = threadIdx.x >> 6, lane = threadIdx.x & 63;
    const int i = blockIdx.x * 4 + w, h = blockIdx.y, b = blockIdx.z;
    float* a = abuf[w];
    float d1 = 0.f, d2 = 0.f;
    d1 = wave_sum(lq1[lane] * lk1[lane]); d2 = wave_sum(lq2[lane] * lk2[lane]);
    const float lam = expf(d1) - expf(d2) + LAMBDA_INIT;
    const float slope = exp2f(-8.0f * (float)(h + 1) / (float)NH);
    const size_t rowq = (size_t)(b * SEQ + i) * NPROJ;
    for (int c = 0; c < 2; ++c) {
        float q[64];
#pragma unroll
        for (int d = 0; d < 64; ++d) q[d] = bf2f(proj[rowq + h * 128 + c * 64 + d]);
        float sc[32]; float mx = -3.0e38f;
#pragma unroll
        for (int t = 0; t < 32; ++t) { const int j = lane + 64 * t; const bf16_t* kr = proj + (size_t)(b * SEQ + j) * NPROJ + 512 + h * 128 + c * 64;
            float s = 0.f;
#pragma unroll
            for (int d = 0; d < 64; ++d) s = fmaf(q[d], bf2f(kr[d]), s);
            s = s * 0.125f - slope * fabsf((float)(i - j)); sc[t] = s; mx = fmaxf(mx, s); }
        mx = wave_max(mx); float l = 0.f;
#pragma unroll
        for (int t = 0; t < 32; ++t) { sc[t] = expf(sc[t] - mx); l += sc[t]; }
        l = wave_sum(l); const float il = 1.f / l;
#pragma unroll
        for (int t = 0; t < 32; ++t) { const int j = lane + 64 * t; if (c == 0) a[j] = sc[t] * il; else a[j] -= lam * sc[t] * il; }
    }
    __syncthreads();
    float o0 = 0.f, o1 = 0.f;
    for (int j = 0; j < SEQ; ++j) { const bf16_t* vr = proj + (size_t)(b * SEQ + j) * NPROJ + 1024 + h * 128; const float aj = a[j]; o0 = fmaf(aj, bf2f(vr[lane]), o0); o1 = fmaf(aj, bf2f(vr[64 + lane]), o1); }
    const float ms = wave_sum(o0 * o0 + o1 * o1) * (1.f / 128.f); const float r = rsqrtf(ms + EPS) * (1.f - LAMBDA_INIT);
    bf16_t* orow = mix + (size_t)(b * SEQ + i) * DM + h * 128;
    orow[lane] = f2bf(o0 * r * subg[lane]); orow[64 + lane] = f2bf(o1 * r * subg[64 + lane]);
}

__global__ void __launch_bounds__(64) k_ssm_naive(const bf16_t* __restrict__ proj, float* __restrict__ Y, const float* __restrict__ lam_re, const float* __restrict__ lam_im, const float* __restrict__ log_dt,
                                                  const float* __restrict__ b_re, const float* __restrict__ b_im, const float* __restrict__ c_re, const float* __restrict__ c_im) {
    __shared__ float xs[2][64]; __shared__ float cs[2][64][17];
    const int g = blockIdx.x, b = blockIdx.y, p = threadIdx.x;
    for (int dir = 0; dir < 2; ++dir) {
        const int pg = (dir * NG + g);
        const float dt = expf(log_dt[pg]), lr = lam_re[pg * NP + p], li = lam_im[pg * NP + p];
        const float mag = expf(lr * dt), ang = li * dt, ar = mag * cosf(ang), ai = mag * sinf(ang), nr = ar - 1.f, den = lr * lr + li * li;
        const float cr = (nr * lr + ai * li) / den, ci = (ai * lr - nr * li) / den;
        float bbr[16], bbi[16];
#pragma unroll
        for (int h = 0; h < 16; ++h) { const float br = b_re[(size_t)(pg * NP + p) * GC + h], bi = b_im[(size_t)(pg * NP + p) * GC + h]; bbr[h] = cr * br - ci * bi; bbi[h] = cr * bi + ci * br; }
        __syncthreads();
        for (int h = 0; h < 16; ++h) { cs[0][p][h] = c_re[(size_t)(pg * GC + h) * NP + p]; cs[1][p][h] = c_im[(size_t)(pg * GC + h) * NP + p]; }
        __syncthreads();
        float xr = 0.f, xi = 0.f;
        for (int s = 0; s < SEQ; ++s) {
            const int t = dir == 0 ? s : SEQ - 1 - s;
#if DBG_CHUNKLOCAL
            if ((s & 15) == 0) { xr = 0.f; xi = 0.f; }
#endif
            const bf16_t* ur = proj + (size_t)(b * SEQ + t) * NPROJ + 1536 + g * GC;
            float bur = 0.f, bui = 0.f;
#pragma unroll
            for (int h = 0; h < 16; ++h) { const float u = bf2f(ur[h]); bur = fmaf(bbr[h], u, bur); bui = fmaf(bbi[h], u, bui); }
            const float nxr = ar * xr - ai * xi + bur, nxi = ar * xi + ai * xr + bui; xr = nxr; xi = nxi;
            xs[0][p] = xr; xs[1][p] = xi;
            __syncthreads();
            if (p < 16) { float y = 0.f;
                for (int q = 0; q < 64; ++q) y += cs[0][q][p] * xs[0][q] - cs[1][q][p] * xs[1][q];
                float* yp = Y + (size_t)(b * SEQ + t) * SSMW + g * GC + p; if (dir == 0) *yp = y; else *yp += y; }
            __syncthreads();
        }
    }
}
__global__ void __launch_bounds__(256) k_ssm_post(const float* __restrict__ Y, const bf16_t* __restrict__ proj, const float* __restrict__ dskip, bf16_t* __restrict__ Z) {
    const size_t idx = (size_t)blockIdx.x * 256 + threadIdx.x; const int row = (int)(idx / SSMW), ch = (int)(idx % SSMW);
    const float u = bf2f(proj[(size_t)row * NPROJ + 1536 + ch]); const float y = Y[idx] + dskip[ch] * u;
    Z[idx] = f2bf(0.5f * y * (1.f + erff(y * 0.70710678118654752f)));
}


__global__ void __launch_bounds__(256) k_cmp_bf16(const bf16_t* __restrict__ a, const bf16_t* __restrict__ b, size_t n, unsigned* metric) {
    float m = 0.f;
    for (size_t i = (size_t)blockIdx.x * 256 + threadIdx.x; i < n; i += (size_t)gridDim.x * 256) { float d = fabsf(bf2f(a[i]) - bf2f(b[i])); if (!(d < 1e4f)) d = 1e4f; m = fmaxf(m, d); }
    m = wave_max(m);
    if ((threadIdx.x & 63) == 0) atomicMax(metric, __float_as_uint(m));
}
__global__ void k_inject(float* out, const unsigned* metric, float scale) { if (threadIdx.x == 0 && blockIdx.x == 0) out[0] += fminf(scale * __uint_as_float(*metric), 1e4f); }

__global__ void __launch_bounds__(256) k_tpart_naive(const bf16_t* __restrict__ proj, const bf16_t* __restrict__ KC, bf16_t* __restrict__ Zo) {
    const size_t idx = (size_t)blockIdx.x * 256 + threadIdx.x; const int row = (int)(idx / SSMW), ch = (int)(idx % SSMW), g = ch >> 4, hp = ch & 15, i = row & 15, row0 = row - i;
    float y = 0.f;
    for (int j = 0; j < 16; ++j) for (int h = 0; h < 16; ++h) y += bf2f(KC[(size_t)g * 8192 + (i - j + 15) * 256 + hp * 16 + h]) * bf2f(proj[(size_t)(row0 + j) * NPROJ + 1536 + g * 16 + h]);
    Zo[idx] = f2bf(0.5f * y * (1.f + erff(y * 0.70710678118654752f)));
}

__global__ void __launch_bounds__(256) k_kc_naive(bf16_t* __restrict__ KC2, const float* lam_re, const float* lam_im, const float* log_dt, const float* b_re, const float* b_im, const float* c_re, const float* c_im, const float* dskip) {
    const int idx = blockIdx.x * 256 + threadIdx.x; if (idx >= NG * 31 * 256) return;
    const int g = idx / (31 * 256), r = idx % (31 * 256), dd = r / 256 - 15, hp = (r % 256) / 16, h = r % 16; const int e = dd < 0 ? -dd : dd;
    float acc = 0.f;
    for (int d = 0; d < 2; ++d) {
        if ((dd > 0 && d == 1) || (dd < 0 && d == 0)) continue;
        const float dt = expf(log_dt[d * NG + g]);
        for (int p = 0; p < 64; ++p) {
            const float lr = lam_re[(d * NG + g) * NP + p], li = lam_im[(d * NG + g) * NP + p];
            const float mag = expf(lr * dt), ang = li * dt, ar = mag * cosf(ang), ai = mag * sinf(ang), nr = ar - 1.f, den = lr * lr + li * li;
            const float cr = (nr * lr + ai * li) / den, ci = (ai * lr - nr * li) / den;
            const float me = expf((float)e * lr * dt), pr = me * cosf((float)e * ang), pi = me * sinf((float)e * ang);
            const float fr = pr * cr - pi * ci, fi = pr * ci + pi * cr;
            const float br = b_re[(size_t)((d * NG + g) * NP + p) * GC + h], bi = b_im[(size_t)((d * NG + g) * NP + p) * GC + h];
            const float er = fr * br - fi * bi, ei = fr * bi + fi * br;
            acc += c_re[(size_t)((d * NG + g) * GC + hp) * NP + p] * er - c_im[(size_t)((d * NG + g) * GC + hp) * NP + p] * ei;
        }
    }
    if (dd == 0 && hp == h) acc += dskip[g * GC + h];
    KC2[(size_t)g * 8192 + (dd + 15) * 256 + hp * 16 + h] = f2bf(acc);
}

__global__ void __launch_bounds__(256) k_s_naive(const bf16_t* __restrict__ proj, const bf16_t* __restrict__ WST, bf16_t* __restrict__ S2) {
    const size_t idx = (size_t)blockIdx.x * 256 + threadIdx.x; const int np = (int)(idx & 255), c = (int)((idx >> 8) & 127), g = (int)((idx >> 15) & 31), b = (int)(idx >> 20);
    float s = 0.f;
    for (int j = 0; j < 16; ++j) for (int h = 0; h < 16; ++h) s += bf2f(WST[(size_t)g * 65536 + (size_t)np * 256 + j * 16 + h]) * bf2f(proj[(size_t)(b * SEQ + c * 16 + j) * NPROJ + 1536 + g * 16 + h]);
    S2[idx] = f2bf(s);
}
__global__ void __launch_bounds__(128) k_x_naive(bf16_t* __restrict__ S2, const float* __restrict__ A16) {
    const int bg = blockIdx.x, g = bg & 31, d = threadIdx.x >> 6, p = threadIdx.x & 63;
    const float ar = A16[(size_t)((d * NG + g) * NP + p) * 2], ai = A16[(size_t)((d * NG + g) * NP + p) * 2 + 1];
    bf16_t* col = S2 + (size_t)bg * 128 * 256 + d * 128 + p; float xr = 0.f, xi = 0.f;
    for (int k = 0; k < 128; ++k) { const int c = d == 0 ? k : 127 - k; const float sr = bf2f(col[c * 256]), si = bf2f(col[c * 256 + 64]);
        col[c * 256] = f2bf(xr); col[c * 256 + 64] = f2bf(xi); const float nr = ar * xr - ai * xi + sr, ni = ar * xi + ai * xr + si; xr = nr; xi = ni; }
}

__global__ void __launch_bounds__(256) k_absmax_bf16(const bf16_t* __restrict__ a, size_t n, unsigned* metric) {
    float m = 0.f;
    for (size_t i = (size_t)blockIdx.x * 256 + threadIdx.x; i < n; i += (size_t)gridDim.x * 256) { float d = fabsf(bf2f(a[i])); if (!(d < 1e4f)) d = 1e4f; m = fmaxf(m, d); }
    m = wave_max(m);
    if ((threadIdx.x & 63) == 0) atomicMax(metric, __float_as_uint(m));
}
#ifndef ONE_LAUNCH
#define ONE_LAUNCH 1
#endif
#ifndef DBG_NAIVE_SSM
#define DBG_NAIVE_SSM 0
#define DBG_SCALE 100.0f
#define DBG_TPART 0
#ifndef DBG_SEL
#define DBG_SEL 0
#endif
#endif
static void launch_mk(Args a, int lo, int hi, int grid, hipStream_t stream) {
    a.ph_lo = lo; a.ph_hi = hi;
    if (hi - lo > 1) { void* kargs[] = {&a}; hipError_t e = hipLaunchCooperativeKernel((const void*)mk_fwd, dim3(grid), dim3(NWAVES * 64), kargs, LDS_BYTES, stream);
        if (e != hipSuccess) fprintf(stderr, "cooperative launch failed: %s (grid %d)\n", hipGetErrorString(e), grid); }
    else hipLaunchKernelGGL(mk_fwd, dim3(grid), dim3(NWAVES * 64), LDS_BYTES, stream, a);
}
extern "C" void kernel_launch(void* const* d_in, const int* in_sizes, int n_in, void* d_out, int out_size, void* d_ws, size_t ws_size, hipStream_t stream) {
    (void)in_sizes; (void)n_in; (void)out_size; (void)ws_size;
    static int grid = 0;
    if (grid == 0) {
        int dev = 0, cus = 0, per_cu = 0;
        (void)hipGetDevice(&dev); (void)hipDeviceGetAttribute(&cus, hipDeviceAttributeMultiprocessorCount, dev);
        if (hipFuncSetAttribute((const void*)mk_fwd, hipFuncAttributeMaxDynamicSharedMemorySize, LDS_BYTES) != hipSuccess) { fprintf(stderr, "hipFuncSetAttribute failed\n"); grid = -1; return; }
        (void)hipOccupancyMaxActiveBlocksPerMultiprocessor(&per_cu, (const void*)mk_fwd, NWAVES * 64, LDS_BYTES);
        (void)hipGetLastError();
        if (per_cu < 1) per_cu = 1;
        grid = cus * 1;
        if (grid != 256) fprintf(stderr, "kernel_launch: %d CUs (occupancy query %d/CU)\n", cus, per_cu);
    }
    if (grid < 0) return;
    const float* x = (const float*)d_in[0]; const float* g1 = (const float*)d_in[1]; const float* w_in = (const float*)d_in[2];
    const float* lq1 = (const float*)d_in[3]; const float* lk1 = (const float*)d_in[4]; const float* lq2 = (const float*)d_in[5]; const float* lk2 = (const float*)d_in[6];
    const float* subg = (const float*)d_in[7]; const float* s_lre = (const float*)d_in[8]; const float* s_lim = (const float*)d_in[9]; const float* s_ldt = (const float*)d_in[10];
    const float* s_bre = (const float*)d_in[11]; const float* s_bim = (const float*)d_in[12]; const float* s_cre = (const float*)d_in[13]; const float* s_cim = (const float*)d_in[14];
    const float* s_d = (const float*)d_in[15]; const float* w_glu = (const float*)d_in[16]; const float* w_out = (const float*)d_in[18];
    const float* g2 = (const float*)d_in[19]; const float* w1 = (const float*)d_in[20]; const float* w2 = (const float*)d_in[21];
    unsigned char* ws = (unsigned char*)d_ws;
    bf16_t* WIN = (bf16_t*)(ws + WS_WIN); bf16_t* WGLU = (bf16_t*)(ws + WS_WGLU); bf16_t* WOUT = (bf16_t*)(ws + WS_WOUT); bf16_t* W1T = (bf16_t*)(ws + WS_W1); bf16_t* W2T = (bf16_t*)(ws + WS_W2);
    bf16_t* XN = (bf16_t*)(ws + WS_XN); bf16_t* PROJ = (bf16_t*)(ws + WS_PROJ); bf16_t* MIX = (bf16_t*)(ws + WS_MIX); bf16_t* Z = (bf16_t*)(ws + WS_Z); float* Y = (float*)(ws + WS_Y);
    (void)hipMemsetAsync(ws + WS_CTL, 0, CTL_ZERO_BYTES, stream);
    Args a{};
    for (int i = 0; i < 23; ++i) a.in[i] = (const float*)d_in[i];
    a.out = (float*)d_out; a.ws = ws;

#if ONE_LAUNCH
    a.ssm_in = 1;
    launch_mk(a, 0, 8, grid, stream);
#else
    launch_mk(a, 0, 1, grid, stream);
    launch_mk(a, 1, 2, grid, stream);
    a.ssm_in = 1;
    launch_mk(a, 2, 3, grid, stream);
#if DBG_NAIVE_SSM
    { unsigned* mw = (unsigned*)(ws + 512 * 1024);
      k_absmax_bf16<<<1024, 256, 0, stream>>>((const bf16_t*)(ws + WS_WST), (size_t)NG * 65536, mw + 192);
      k_absmax_bf16<<<1024, 256, 0, stream>>>((const bf16_t*)(ws + WS_WCY), (size_t)NG * 65536, mw + 256);
      k_s_naive<<<BATCH * NG * 128 * 256 / 256, 256, 0, stream>>>(PROJ, (const bf16_t*)(ws + WS_WST), (bf16_t*)(ws + 184 * MiB));
      k_cmp_bf16<<<1024, 256, 0, stream>>>((const bf16_t*)(ws + 200 * MiB), (const bf16_t*)(ws + 184 * MiB), (size_t)BATCH * NG * 128 * 256, mw + 64);
      k_absmax_bf16<<<1024, 256, 0, stream>>>((const bf16_t*)(ws + 200 * MiB), (size_t)BATCH * NG * 128 * 256, mw + 320);
      k_absmax_bf16<<<1024, 256, 0, stream>>>((const bf16_t*)(ws + 184 * MiB), (size_t)BATCH * NG * 128 * 256, mw + 384);
      k_x_naive<<<BATCH * NG, 128, 0, stream>>>((bf16_t*)(ws + 184 * MiB), (const float*)(ws + WS_A16));
      k_cmp_bf16<<<1024, 256, 0, stream>>>((const bf16_t*)(ws + 216 * MiB), (const bf16_t*)(ws + 184 * MiB), (size_t)BATCH * NG * 128 * 256, mw + 128); }
#if DBG_TPART
    k_kc_naive<<<(NG * 31 * 256 + 255) / 256, 256, 0, stream>>>((bf16_t*)(ws + 250 * MiB), s_lre, s_lim, s_ldt, s_bre, s_bim, s_cre, s_cim, s_d);
    k_tpart_naive<<<M_TOK * SSMW / 256, 256, 0, stream>>>(PROJ, (const bf16_t*)(ws + 250 * MiB), (bf16_t*)(ws + 232 * MiB));
#else
    (void)hipMemcpyAsync(ws + 232 * MiB, Z, (size_t)M_TOK * SSMW * 2, hipMemcpyDeviceToDevice, stream);
#endif
    k_ssm_naive<<<dim3(NG, BATCH), 64, 0, stream>>>(PROJ, Y, s_lre, s_lim, s_ldt, s_bre, s_bim, s_cre, s_cim);
    k_ssm_post<<<M_TOK * SSMW / 256, 256, 0, stream>>>(Y, PROJ, s_d, Z);
#endif
#if DBG_NAIVE_SSM
    k_cmp_bf16<<<1024, 256, 0, stream>>>((const bf16_t*)(ws + 232 * MiB), Z, (size_t)M_TOK * SSMW, (unsigned*)(ws + 512 * 1024));
#endif
    launch_mk(a, 3, 8, grid, stream);
#endif
#if DBG_NAIVE_SSM
    k_inject<<<1, 64, 0, stream>>>((float*)d_out, (const unsigned*)(ws + 512 * 1024) + 64 * DBG_SEL, DBG_SCALE);
#endif
}
```
